# Optimizing an MI355X kernel written in HIP

```python
import math
import jax, jax.numpy as jnp
from jax import lax
import numpy as np

D_MODEL = 1024
BATCH = 16
SEQ = 256
DEPTH = 4
DEC_BATCH = 4
DEC_SEQ = 2048
PAST_LEN = 512

GRID_W = 64
HEAD_DIM = 64
N_Q_HEADS = 8
N_KV_HEADS = 2
Q_PER_KV = N_Q_HEADS // N_KV_HEADS
ATTN_W = N_Q_HEADS * HEAD_DIM
KV_W = N_KV_HEADS * HEAD_DIM
WINDOW = 128
BLOCK = 128
ATTN_SCALE = 0.125
ROPE_THETA = 10000.0
NEG = -1e30
RWKV_HEADS = 4
RWKV_W = RWKV_HEADS * HEAD_DIM
DECAY_RANK = 64
ICLR_RANK = 64
GATE_RANK = 128
SHIFT_WIDTH = 3
DECAY_SCALE = 0.6065306597126334
GN_EPS = 64e-5
RWKV_IN_W = 3 * RWKV_W + GATE_RANK + 2 * DECAY_RANK + 2 * ICLR_RANK
RWKV_SPLITS = (RWKV_W, 2 * RWKV_W, 3 * RWKV_W, 3 * RWKV_W + GATE_RANK,
               3 * RWKV_W + GATE_RANK + 2 * DECAY_RANK)
FNET_GROUPS = 4
FNET_W = FNET_GROUPS * HEAD_DIM
MIX_W = ATTN_W + RWKV_W + FNET_W
IN_W = ATTN_W + 2 * KV_W + RWKV_IN_W + FNET_W
IN_SPLITS = (ATTN_W, ATTN_W + KV_W, ATTN_W + 2 * KV_W, ATTN_W + 2 * KV_W + RWKV_IN_W)
D_FF = -(-8 * D_MODEL // (3 * 256)) * 256
RMS_EPS = 1e-6

kernel_name = "hybrid_dit_gqa_rwkv7_fnet_step"


def rmsnorm(x, g):
    xf = x.astype(jnp.float32)
    y = xf * lax.rsqrt(jnp.mean(xf * xf, axis=-1, keepdims=True) + RMS_EPS)
    return (y * g.astype(jnp.float32)).astype(x.dtype)


def modulate(h, shift, scale):
    return h * (1.0 + scale) + shift


def axial_rope(x):
    T = x.shape[1]
    n_rows = T // GRID_W
    row = jnp.repeat(jnp.arange(n_rows), GRID_W)
    col = jnp.tile(jnp.arange(GRID_W), n_rows)
    half = HEAD_DIM // 2
    quarter = half // 2
    inv = ROPE_THETA ** (-jnp.arange(quarter, dtype=jnp.float32) / quarter)

    def rot(xh, pos):
        ang = pos.astype(jnp.float32)[:, None] * inv[None, :]
        cos = jnp.cos(ang)[None, :, None, :]
        sin = jnp.sin(ang)[None, :, None, :]
        x1, x2 = xh[..., :quarter], xh[..., quarter:]
        return jnp.concatenate([x1 * cos - x2 * sin, x2 * cos + x1 * sin], axis=-1)

    xf = x.astype(jnp.float32)
    out = jnp.concatenate([rot(xf[..., :half], row), rot(xf[..., half:], col)], axis=-1)
    return out.astype(x.dtype)


def softmax_with_sink(s, sink):
    sk = sink.astype(jnp.float32).reshape(N_KV_HEADS, Q_PER_KV, 1, 1)
    m = jnp.maximum(jnp.max(s, axis=-1, keepdims=True), sk)
    e = jnp.exp(s - m)
    return e / (jnp.sum(e, axis=-1, keepdims=True) + jnp.exp(sk - m))


def context_attention(q, k, v, sink):
    B, C = q.shape[:2]
    nqb = C // BLOCK
    qb = jnp.moveaxis(q.reshape(B, nqb, BLOCK, N_KV_HEADS, Q_PER_KV, HEAD_DIM), 1, 0)
    kf = k.astype(jnp.float32)
    vf = v.astype(jnp.float32)

    def one_block(qblk):
        s = jnp.einsum('bqkgd,bckd->bkgqc', qblk.astype(jnp.float32), kf) * ATTN_SCALE
        p = softmax_with_sink(s, sink)
        return jnp.einsum('bkgqc,bckd->bqkgd', p, vf)

    o = lax.map(one_block, qb)
    return jnp.moveaxis(o, 0, 1).reshape(B, C, ATTN_W).astype(q.dtype)


def latent_attention(q, k, v, k_ctx, v_ctx, sink):
    B, T = q.shape[:2]
    nb = T // BLOCK
    qb = q.reshape(B, nb, BLOCK, N_KV_HEADS, Q_PER_KV, HEAD_DIM).astype(jnp.float32)
    pad = ((0, 0), (BLOCK, BLOCK), (0, 0), (0, 0))
    kp = jnp.pad(k, pad).reshape(B, nb + 2, BLOCK, N_KV_HEADS, HEAD_DIM)
    vp = jnp.pad(v, pad).reshape(B, nb + 2, BLOCK, N_KV_HEADS, HEAD_DIM)
    kband = jnp.concatenate([kp[:, :-2], kp[:, 1:-1], kp[:, 2:]], axis=2).astype(jnp.float32)
    vband = jnp.concatenate([vp[:, :-2], vp[:, 1:-1], vp[:, 2:]], axis=2).astype(jnp.float32)
    s_lat = jnp.einsum('bnqkgd,bnskd->bnkgqs', qb, kband) * ATTN_SCALE
    s_ctx = jnp.einsum('bnqkgd,bckd->bnkgqc', qb, k_ctx.astype(jnp.float32)) * ATTN_SCALE
    qi = jnp.arange(BLOCK)[:, None]
    kj = jnp.arange(3 * BLOCK)[None, :]
    in_window = jnp.abs(kj - BLOCK - qi) <= WINDOW
    kpos = jnp.arange(nb)[:, None, None] * BLOCK - BLOCK + kj[None]
    mask = in_window[None] & (kpos >= 0) & (kpos < T)
    s_lat = jnp.where(mask[None, :, None, None], s_lat, NEG)
    p = softmax_with_sink(jnp.concatenate([s_lat, s_ctx], axis=-1), sink)
    o = (jnp.einsum('bnkgqs,bnskd->bnqkgd', p[..., :3 * BLOCK], vband)
         + jnp.einsum('bnkgqc,bckd->bnqkgd', p[..., 3 * BLOCK:], v_ctx.astype(jnp.float32)))
    return o.reshape(B, T, ATTN_W).astype(q.dtype)


def centred_shift(u, w):
    T = u.shape[1]
    half = SHIFT_WIDTH // 2
    up = jnp.pad(u, ((0, 0), (half, half), (0, 0)))
    return sum(up[:, j:j + T] * w[j] for j in range(SHIFT_WIDTH))


def rwkv_heads(t):
    return t.reshape(t.shape[:-1] + (RWKV_HEADS, HEAD_DIM))


def rwkv_scan(s0, r, w, k, v, kk, a, reverse):
    def step(S, inp):
        r_t, w_t, k_t, v_t, kk_t, a_t = inp
        S = (S * w_t[:, :, None, :]
             - jnp.einsum('bhvk,bhk->bhv', S, kk_t)[..., None] * (kk_t * a_t)[:, :, None, :]
             + v_t[..., None] * k_t[:, :, None, :])
        return S, jnp.einsum('bhvk,bhk->bhv', S, r_t)

    xs = tuple(jnp.moveaxis(t, 1, 0) for t in (r, w, k, v, kk, a))
    s_fin, ys = lax.scan(step, s0, xs, reverse=reverse)
    return s_fin, jnp.moveaxis(ys, 0, 1)


def rwkv_mix(u, s_fwd, s_bwd, p):
    B, T = u.shape[:2]
    u = centred_shift(u, p['rwkv_shift_w']).astype(jnp.float32)
    r, k, v, gd, wd, ad = jnp.split(u, RWKV_SPLITS, axis=-1)
    wd = wd.reshape(B, T, 2, DECAY_RANK)
    ad = ad.reshape(B, T, 2, ICLR_RANK)
    log_w = -DECAY_SCALE * jax.nn.sigmoid(
        p['rwkv_w0'] + jnp.einsum('btdr,drc->btdc', jnp.tanh(wd), p['rwkv_w_up']))
    a = jax.nn.sigmoid(p['rwkv_a0'] + jnp.einsum('btdr,drc->btdc', ad, p['rwkv_a_up']))
    g = jax.nn.sigmoid(gd) @ p['rwkv_g_up']
    r, k, v = rwkv_heads(r), rwkv_heads(k), rwkv_heads(v)
    kk = k * rwkv_heads(p['rwkv_k_k'])
    kk = kk * lax.rsqrt(jnp.sum(kk * kk, axis=-1, keepdims=True) + 1e-12)
    k_a = rwkv_heads(p['rwkv_k_a'])
    ys = []
    finals = []
    for d, (s0, rev) in enumerate(((s_fwd, False), (s_bwd, True))):
        a_d = rwkv_heads(a[:, :, d])
        k_d = k * (1.0 + (a_d - 1.0) * k_a)
        s_fin, y_d = rwkv_scan(s0.astype(jnp.float32), r, jnp.exp(rwkv_heads(log_w[:, :, d])),
                               k_d, v, kk, a_d, rev)
        ys.append(y_d)
        finals.append(s_fin)
    y = ys[0] + ys[1]
    mean = jnp.mean(y, axis=-1, keepdims=True)
    var = jnp.mean(jnp.square(y - mean), axis=-1, keepdims=True)
    y = ((y - mean) * lax.rsqrt(var + GN_EPS)).reshape(B, T, RWKV_W) * p['rwkv_ln_g'] + p['rwkv_ln_b']
    bonus = (jnp.sum(r * k * p['rwkv_r_k'], axis=-1, keepdims=True) * v).reshape(B, T, RWKV_W)
    return (y + bonus) * g, finals[0], finals[1]


def fourier_mix(u):
    B, T = u.shape[:2]
    z = u.astype(jnp.float32).reshape(B, T, FNET_GROUPS, HEAD_DIM)
    y = jnp.fft.fftn(z, axes=(1, 3), norm='ortho').real
    return y.reshape(B, T, FNET_W).astype(u.dtype)


def split_projection(h, w_in):
    B, T = h.shape[:2]
    q, k, v, u_rwkv, u_fnet = jnp.split(h @ w_in, IN_SPLITS, axis=-1)
    q = q.reshape(B, T, N_Q_HEADS, HEAD_DIM)
    k = k.reshape(B, T, N_KV_HEADS, HEAD_DIM)
    v = v.reshape(B, T, N_KV_HEADS, HEAD_DIM)
    return q, k, v, u_rwkv, u_fnet


def merge_and_ffn(x, o_attn, o_rwkv, o_fnet, mod, p):
    _, _, g1, sh2, sc2, g2 = mod
    o = jnp.concatenate([o_attn.astype(x.dtype), o_rwkv.astype(x.dtype), o_fnet.astype(x.dtype)],
                        axis=-1) @ p['w_out']
    x = x + g1 * o
    h = modulate(rmsnorm(x, p['norm_ffn_g']), sh2, sc2)
    gt, up = jnp.split(h @ p['ffn_w_in'], 2, axis=-1)
    return x + g2 * ((jax.nn.silu(gt) * up) @ p['ffn_w_out'])


def context_layer(x, mod_vec, p):
    mod = jnp.split(mod_vec, 6, axis=-1)
    h = modulate(rmsnorm(x, p['norm_mix_g']), mod[0], mod[1])
    q, k, v, u_r, u_f = split_projection(h, p['w_in'])
    o_attn = context_attention(q, k, v, p['attn_sink'])
    s0 = jnp.zeros((x.shape[0], RWKV_HEADS, HEAD_DIM, HEAD_DIM), jnp.float32)
    o_rwkv, s_f, s_b = rwkv_mix(u_r, s0, s0, p)
    o_fnet = fourier_mix(u_f)
    x = merge_and_ffn(x, o_attn, o_rwkv, o_fnet, mod, p)
    return x, k, v, jnp.stack([s_f, s_b], axis=1)


def latent_layer(x, mod_vec, k_ctx, v_ctx, s_ctx, p):
    mod = jnp.split(mod_vec[:, None, :], 6, axis=-1)
    h = modulate(rmsnorm(x, p['norm_mix_g']), mod[0], mod[1])
    q, k, v, u_r, u_f = split_projection(h, p['w_in'])
    o_attn = latent_attention(axial_rope(q), axial_rope(k), v, k_ctx, v_ctx, p['attn_sink'])
    o_rwkv, _, _ = rwkv_mix(u_r, s_ctx[:, 0], s_ctx[:, 1], p)
    o_fnet = fourier_mix(u_f)
    return merge_and_ffn(x, o_attn, o_rwkv, o_fnet, mod, p)


def setup_inputs(seed: int = 0) -> dict:
    key = jax.random.key(seed)
    ks = jax.random.split(key, 28)

    def n(k, shape, s):
        return s * jax.random.normal(k, shape, jnp.float32)

    L = DEPTH
    return {
        'x_prompt': n(ks[0], (BATCH, SEQ, D_MODEL), 1.0),
        'x_sample': n(ks[1], (DEC_BATCH, DEC_SEQ, D_MODEL), 1.0),
        'cache_k': n(ks[2], (DEC_BATCH, L, PAST_LEN, N_KV_HEADS, HEAD_DIM), 1.0),
        'cache_v': n(ks[3], (DEC_BATCH, L, PAST_LEN, N_KV_HEADS, HEAD_DIM), 1.0),
        'state_rwkv': n(ks[4], (DEC_BATCH, L, 2, RWKV_HEADS, HEAD_DIM, HEAD_DIM), 0.5),
        'c': n(ks[5], (DEC_BATCH, D_MODEL), 1.0),
        'c_ctx': n(ks[6], (D_MODEL,), 1.0),
        'w_ada': n(ks[7], (L, D_MODEL, 6 * D_MODEL), 0.3 * D_MODEL ** -0.5),
        'b_ada': n(ks[8], (L, 6 * D_MODEL), 0.02),
        'norm_mix_g': 1.0 + n(ks[9], (L, D_MODEL), 0.05),
        'norm_ffn_g': 1.0 + n(ks[10], (L, D_MODEL), 0.05),
        'w_in': n(ks[11], (L, D_MODEL, IN_W), D_MODEL ** -0.5),
        'w_out': n(ks[12], (L, MIX_W, D_MODEL), MIX_W ** -0.5),
        'attn_sink': n(ks[13], (L, N_Q_HEADS), 0.5),
        'rwkv_shift_w': jnp.array([0.25, 0.5, 0.25], jnp.float32)[None, :, None]
                        + n(ks[14], (L, SHIFT_WIDTH, RWKV_IN_W), 0.05),
        'rwkv_w0': jax.random.uniform(ks[15], (L, 2, RWKV_W), jnp.float32, -5.0, 1.0),
        'rwkv_w_up': n(ks[16], (L, 2, DECAY_RANK, RWKV_W), 0.1 * DECAY_RANK ** -0.5),
        'rwkv_a0': n(ks[17], (L, 2, RWKV_W), 0.5),
        'rwkv_a_up': n(ks[18], (L, 2, ICLR_RANK, RWKV_W), 0.1 * ICLR_RANK ** -0.5),
        'rwkv_g_up': n(ks[19], (L, GATE_RANK, RWKV_W), GATE_RANK ** -0.5),
        'rwkv_k_k': 0.85 + n(ks[20], (L, RWKV_W), 0.05),
        'rwkv_k_a': 1.0 + n(ks[21], (L, RWKV_W), 0.05),
        'rwkv_r_k': n(ks[22], (L, RWKV_HEADS, HEAD_DIM), 0.1),
        'rwkv_ln_g': 1.0 + n(ks[23], (L, RWKV_W), 0.05),
        'rwkv_ln_b': n(ks[24], (L, RWKV_W), 0.02),
        'ffn_w_in': n(ks[25], (L, D_MODEL, 2 * D_FF), D_MODEL ** -0.5),
        'ffn_w_out': n(ks[26], (L, D_FF, D_MODEL), D_FF ** -0.5),
        'norm_final_g': 1.0 + n(ks[27], (D_MODEL,), 0.05),
    }


def reference(x_prompt, x_sample, cache_k, cache_v, state_rwkv, c, c_ctx,
              w_ada, b_ada, norm_mix_g, norm_ffn_g, w_in, w_out, attn_sink,
              rwkv_shift_w, rwkv_w0, rwkv_w_up, rwkv_a0, rwkv_a_up, rwkv_g_up,
              rwkv_k_k, rwkv_k_a, rwkv_r_k, rwkv_ln_g, rwkv_ln_b,
              ffn_w_in, ffn_w_out, norm_final_g):
    y_p = x_prompt
    y_s = x_sample
    new_k, new_v, new_s = [], [], []
    for l in range(DEPTH):
        p = {
            'norm_mix_g': norm_mix_g[l], 'norm_ffn_g': norm_ffn_g[l],
            'w_in': w_in[l], 'w_out': w_out[l], 'attn_sink': attn_sink[l],
            'rwkv_shift_w': rwkv_shift_w[l], 'rwkv_w0': rwkv_w0[l], 'rwkv_w_up': rwkv_w_up[l],
            'rwkv_a0': rwkv_a0[l], 'rwkv_a_up': rwkv_a_up[l], 'rwkv_g_up': rwkv_g_up[l],
            'rwkv_k_k': rwkv_k_k[l], 'rwkv_k_a': rwkv_k_a[l], 'rwkv_r_k': rwkv_r_k[l],
            'rwkv_ln_g': rwkv_ln_g[l], 'rwkv_ln_b': rwkv_ln_b[l],
            'ffn_w_in': ffn_w_in[l], 'ffn_w_out': ffn_w_out[l],
        }
        mod_ctx = jax.nn.silu(c_ctx) @ w_ada[l] + b_ada[l]
        mod_lat = jax.nn.silu(c) @ w_ada[l] + b_ada[l]
        y_p, k_l, v_l, s_l = context_layer(y_p, mod_ctx, p)
        y_s = latent_layer(y_s, mod_lat, cache_k[:, l], cache_v[:, l], state_rwkv[:, l], p)
        new_k.append(k_l)
        new_v.append(v_l)
        new_s.append(s_l)
    y_prompt = rmsnorm(y_p, norm_final_g)
    y_sample = rmsnorm(y_s, norm_final_g)
    new_cache_k = jnp.stack(new_k, axis=1)
    new_cache_v = jnp.stack(new_v, axis=1)
    new_state_rwkv = jnp.stack(new_s, axis=1)
    return (y_prompt, y_sample, new_cache_k, new_cache_v, new_state_rwkv)
```

```cpp
#include <hip/hip_runtime.h>
#include <hip/hip_cooperative_groups.h>
#include <cstdio>
#include <cstdint>
namespace cg = cooperative_groups;

#ifndef N_LAUNCH_MODE
#define N_LAUNCH_MODE 0
#endif

typedef _Float16 h16;
typedef _Float16 half8 __attribute__((ext_vector_type(8)));
typedef _Float16 half4 __attribute__((ext_vector_type(4)));
typedef float f32x16 __attribute__((ext_vector_type(16)));
typedef float f32x4 __attribute__((ext_vector_type(4)));
#define DI __device__ __forceinline__
#define MFMA16(a, b, c) __builtin_amdgcn_mfma_f32_32x32x16_f16((a), (b), (c), 0, 0, 0)

constexpr int DM = 1024, NTOK = 12288, NCTX = 4096, NL = 4, INW = 2176, DFF = 2816, RW = 256;
constexpr int SMEM_BYTES = 73728;
constexpr int NPH = 2 + NL * 10;

struct Params {
  const float *x_prompt, *x_sample, *cache_k, *cache_v, *state_rwkv, *c, *c_ctx, *w_ada, *b_ada, *norm_mix_g, *norm_ffn_g,
      *w_in, *w_out, *attn_sink, *shift_w, *w0, *w_up, *a0, *a_up, *g_up, *k_k, *k_a, *r_k, *ln_g, *ln_b, *ffn_w_in, *ffn_w_out, *norm_final_g;
  float *x, *out_k, *out_v, *out_s;
  h16 *wt_in, *wt_out, *wt_f1, *wt_f2, *wt_wup, *wt_aup, *wt_gup, *cs64t, *cs_lat, *cs_ctx, *ck, *cvt, *hm, *qh, *kh, *vt, *zt, *pq, *tw, *ad, *sg, *act;
  float *mod, *rope, *ur, *dr, *sh, *kx, *bonus, *gg, *yy;
  unsigned* bar;
  h16* hm2; float *ssq, *bias_in, *bias_f1;
};

typedef const __attribute__((address_space(4))) Params& KP;
DI int tidx() { int t = threadIdx.x; asm volatile("" : "+v"(t)); return t; }
template <int CTRL> DI float dpp_mov(float x) { return __int_as_float(__builtin_amdgcn_update_dpp(0, __float_as_int(x), CTRL, 0xF, 0xF, true)); }
DI float reduce8(float x) {
  x += dpp_mov<0xB1>(x);
  x += dpp_mov<0x4E>(x);
  x += dpp_mov<0x141>(x);
  return x;
}
DI float reduce16(float x) { x = reduce8(x); x += dpp_mov<0x140>(x); return x; }
DI float reduce64(float x) {
  x = reduce16(x);
  x += __shfl_xor(x, 16, 64);
  x += __shfl_xor(x, 32, 64);
  return x;
}
DI float sigmoidf_(float x) { return __builtin_amdgcn_rcpf(1.f + __expf(-x)); }
DI void tokinfo(int tok, int& seq0, int& T, int& t, int& ms) {
  if (tok < NCTX) { T = 256; seq0 = tok & ~255; t = tok & 255; ms = 0; }
  else { int u = tok - NCTX; T = 2048; seq0 = NCTX + (u & ~2047); t = u & 2047; ms = 1 + (u >> 11); }
}
DI half4 to_half4(float a, float b, float c, float d) { half4 v; v[0] = (h16)a; v[1] = (h16)b; v[2] = (h16)c; v[3] = (h16)d; return v; }


#define XB_TMO      128
#define XB_XCNT(j)  (256  + 64 * (j))
#define XB_XSUB(j)  (1280 + 64 * (j))
#define XB_XGEN(j)  (2304 + 64 * (j))
#define XB_TOP      3328
#define XB_TOPGEN   3392
#define XCD_BAR_WORDS 3456
#define XB_SPIN_CAP (1u << 22)
#define LAS __attribute__((address_space(3)))
DI unsigned xb_ld(unsigned* p) { return __hip_atomic_load(p, __ATOMIC_RELAXED, __HIP_MEMORY_SCOPE_AGENT); }
DI unsigned xb_add(unsigned* p, unsigned v) { return __hip_atomic_fetch_add(p, v, __ATOMIC_RELAXED, __HIP_MEMORY_SCOPE_AGENT); }
DI unsigned xb_xcc_id() { return (unsigned)__builtin_amdgcn_s_getreg((3 << 11) | 20) & 0xFu; }
#define XB_SPIN(cond, bar) do { unsigned _sp = 0; while (cond) { __builtin_amdgcn_s_sleep(1); \
    if ((++_sp & 255u) == 0u) { if (xb_ld(&(bar)[XB_TMO])) break; if (_sp > XB_SPIN_CAP) { atomicAdd(&(bar)[XB_TMO], 1u); break; } } } } while (0)
struct XcdBarrier { unsigned* bar; unsigned x; unsigned nloc, nx; };
DI XcdBarrier xcd_barrier_post(unsigned* bar) {
  XcdBarrier b; b.bar = bar; b.x = xb_xcc_id(); b.nloc = 0u; b.nx = 0u;
  if (threadIdx.x == 0) (void)xb_add(&bar[XB_XCNT(b.x)], 1u);
  return b;
}
DI void xcd_barrier_complete(unsigned* bar, unsigned x, unsigned& nloc, unsigned& nx) {
  const unsigned G = gridDim.x * gridDim.y * gridDim.z;
  unsigned sum, cnt, mine, sp = 0u;
  for (;;) {
    sum = 0u; cnt = 0u; mine = 0u;
#pragma unroll
    for (unsigned j = 0; j < 16; ++j) { const unsigned c = xb_ld(&bar[XB_XCNT(j)]); sum += c; cnt += (c > 0u) ? 1u : 0u; mine = (j == x) ? c : mine; }
    if (sum == G) break;
    __builtin_amdgcn_s_sleep(1);
    if ((++sp & 255u) == 0u) { if (xb_ld(&bar[XB_TMO])) break; if (sp > XB_SPIN_CAP) { atomicAdd(&bar[XB_TMO], 1u); break; } }
  }
  nloc = mine > 0u ? mine : 1u; nx = cnt > 0u ? cnt : 1u;
}
DI void xcd_barrier(XcdBarrier& b) {
  asm volatile("s_waitcnt vmcnt(0)" ::: "memory");
  __syncthreads();
  if (threadIdx.x == 0) {
    unsigned* bar = b.bar;
    __builtin_amdgcn_s_waitcnt(0);
    unsigned nloc = b.nloc, nx = b.nx;
    if (nloc == 0u) { xcd_barrier_complete(bar, b.x, nloc, nx); b.nloc = nloc; b.nx = nx; }
    const unsigned old = xb_add(&bar[XB_XSUB(b.x)], 1u);
    const unsigned gen = old / nloc;
    if (old + 1u == (gen + 1u) * nloc) {
      __builtin_amdgcn_fence(__ATOMIC_RELEASE, "agent");
      asm volatile("s_waitcnt vmcnt(0)" ::: "memory");
      const unsigned og = xb_add(&bar[XB_TOP], 1u);
      const unsigned tg = og / nx;
      if (og + 1u == (tg + 1u) * nx) xb_add(&bar[XB_TOPGEN], 1u);
      else XB_SPIN(xb_ld(&bar[XB_TOPGEN]) == tg, bar);
      __builtin_amdgcn_fence(__ATOMIC_ACQUIRE, "agent");
      xb_add(&bar[XB_XGEN(b.x)], 1u);
      asm volatile("s_waitcnt vmcnt(0)" ::: "memory");
    } else {
      XB_SPIN(xb_ld(&bar[XB_XGEN(b.x)]) == gen, bar);
      __builtin_amdgcn_fence(__ATOMIC_ACQUIRE, "agent");
      asm volatile("s_waitcnt vmcnt(0)" ::: "memory");
    }
  }
  __syncthreads();
}

__shared__ __attribute__((aligned(1024))) char g_stage0[40960];
__shared__ __attribute__((aligned(1024))) char g_stage1[40960];
template <int NTI>
DI void gemm_mainloop(const h16* W, int ldw, const h16* X, int ldx, int K, char* smem_unused, f32x16 (&acc)[2][NTI], bool pre_issued = false, const h16* Wn = nullptr, const h16* Xn = nullptr) {
  const int tid = tidx(), lane = tid & 63, wave = tid >> 6;
  const int wf = wave >> 1, wt = wave & 1, r = lane & 31, h = lane >> 5;
#pragma unroll
  for (int a = 0; a < 2; ++a)
#pragma unroll
    for (int b = 0; b < NTI; ++b)
#pragma unroll
      for (int i = 0; i < 16; ++i) acc[a][b][i] = 0.f;
  const int lrow = tid >> 3, lc = (tid & 7) ^ ((tid >> 4) & 7);
  const h16* wp = W + (size_t)lrow * ldw + lc * 8;
  const h16* xp = X + (size_t)lrow * ldx + lc * 8;
  const size_t w32 = (size_t)32 * ldw, x32 = (size_t)32 * ldx;
  const int nk = K >> 6;
  const int swz = (r >> 1) & 7;
#define LDSP(p) ((__attribute__((address_space(3))) unsigned*)(p))
#define STAGE(buf, k0) do { \
    _Pragma("unroll") for (int i_ = 0; i_ < 4; ++i_) __builtin_amdgcn_global_load_lds((const unsigned*)(wp + i_ * w32 + (k0)), LDSP(buf + tid * 16 + i_ * 4096), 16, 0, 0); \
    _Pragma("unroll") for (int i_ = 0; i_ < 2 * NTI; ++i_) __builtin_amdgcn_global_load_lds((const unsigned*)(xp + i_ * x32 + (k0)), LDSP(buf + 16384 + tid * 16 + i_ * 4096), 16, 0, 0); } while (0)
#define DSR(dst, addr, off) asm volatile("ds_read_b128 %0, %1 offset:%2" : "=v"(dst) : "v"(addr), "n"(off))
#define COMPUTE(base) do { \
    f32x4 fa_[2], fb_[3], na_[2], nb_[3]; \
    { const unsigned ad_ = (base) + ((0 * 2 + h) ^ swz) * 16; DSR(fa_[0], ad_ + arow, 0); DSR(fa_[1], ad_ + arow, 4096); DSR(fb_[0], ad_ + brow, 16384); DSR(fb_[1], ad_ + brow, 20480); if (NTI == 3) DSR(fb_[2], ad_ + brow, 24576); } \
    _Pragma("unroll") for (int ks = 0; ks < 4; ++ks) { \
      if (ks < 3) { const unsigned ad_ = (base) + (((ks + 1) * 2 + h) ^ swz) * 16; DSR(na_[0], ad_ + arow, 0); DSR(na_[1], ad_ + arow, 4096); DSR(nb_[0], ad_ + brow, 16384); DSR(nb_[1], ad_ + brow, 20480); if (NTI == 3) DSR(nb_[2], ad_ + brow, 24576); \
                    if (NTI == 3) asm volatile("s_waitcnt lgkmcnt(5)" : "+v"(fa_[0]), "+v"(fa_[1]), "+v"(fb_[0]), "+v"(fb_[1]), "+v"(fb_[2])); \
                    else asm volatile("s_waitcnt lgkmcnt(4)" : "+v"(fa_[0]), "+v"(fa_[1]), "+v"(fb_[0]), "+v"(fb_[1])); } \
      else { if (NTI == 3) asm volatile("s_waitcnt lgkmcnt(0)" : "+v"(fa_[0]), "+v"(fa_[1]), "+v"(fb_[0]), "+v"(fb_[1]), "+v"(fb_[2])); \
             else asm volatile("s_waitcnt lgkmcnt(0)" : "+v"(fa_[0]), "+v"(fa_[1]), "+v"(fb_[0]), "+v"(fb_[1])); } \
      _Pragma("unroll") for (int fi_ = 0; fi_ < 2; ++fi_) _Pragma("unroll") for (int ti_ = 0; ti_ < NTI; ++ti_) \
        acc[fi_][ti_] = MFMA16(__builtin_bit_cast(half8, fa_[fi_]), __builtin_bit_cast(half8, fb_[ti_]), acc[fi_][ti_]); \
      fa_[0] = na_[0]; fa_[1] = na_[1]; fb_[0] = nb_[0]; fb_[1] = nb_[1]; if (NTI == 3) fb_[2] = nb_[2]; } } while (0)
  const unsigned s0 = (unsigned)(size_t)g_stage0, s1 = (unsigned)(size_t)g_stage1;
  const unsigned arow = (wf * 64 + r) * 128, brow = (wt * 32 * NTI + r) * 128;
  if (!pre_issued) STAGE(g_stage0, 0);
  asm volatile("s_waitcnt vmcnt(0)" ::: "memory");
  __syncthreads();
  for (int kt = 0; kt < nk; kt += 2) {
    if (kt + 1 < nk) STAGE(g_stage1, (kt + 1) << 6);
    COMPUTE(s0);
    asm volatile("s_waitcnt vmcnt(0)" ::: "memory");
    __syncthreads();
    if (kt + 1 >= nk) break;
    if (kt + 2 < nk) STAGE(g_stage0, (kt + 2) << 6);
    COMPUTE(s1);
    asm volatile("s_waitcnt vmcnt(0)" ::: "memory");
    __syncthreads();
  }
  if (Wn) {
    wp = Wn + (size_t)lrow * ldw + lc * 8;
    xp = Xn + (size_t)lrow * ldx + lc * 8;
    STAGE(g_stage0, 0);
  }
#undef STAGE
#undef COMPUTE
#undef LDSP
#undef DSR
}

template <int NTI>
DI void gemm_issue_next(const h16* Wn, int ldw, const h16* Xn, int ldx) {
  const int tid = tidx();
  const int lrow = tid >> 3, lc = (tid & 7) ^ ((tid >> 4) & 7);
  const h16* wp = Wn + (size_t)lrow * ldw + lc * 8;
  const h16* xp = Xn + (size_t)lrow * ldx + lc * 8;
  const size_t w32 = (size_t)32 * ldw, x32 = (size_t)32 * ldx;
#pragma unroll
  for (int i = 0; i < 4; ++i) __builtin_amdgcn_global_load_lds((const unsigned*)(wp + i * w32), (__attribute__((address_space(3))) unsigned*)(g_stage0 + tid * 16 + i * 4096), 16, 0, 0);
#pragma unroll
  for (int i = 0; i < 2 * NTI; ++i) __builtin_amdgcn_global_load_lds((const unsigned*)(xp + i * x32), (__attribute__((address_space(3))) unsigned*)(g_stage0 + 16384 + tid * 16 + i * 4096), 16, 0, 0);
}

template <int NTI>
DI void gemm_ring(const h16* W, int ldw, const h16* X, int ldx, int K, f32x16 (&acc)[2][NTI]) {
#pragma unroll
  for (int a = 0; a < 2; ++a)
#pragma unroll
    for (int b = 0; b < NTI; ++b)
#pragma unroll
      for (int i = 0; i < 16; ++i) acc[a][b][i] = 0.f;
  constexpr int SB = 8192 + 4096 * NTI;
  constexpr int NP = 2 + NTI;
  unsigned woff, xoff, a0, b0;
  {
    const int tid = tidx(), lane = tid & 63, wave = tid >> 6, r = lane & 31, h = lane >> 5;
    const int lrow = tid >> 2, lc = (tid & 3) ^ ((tid >> 4) & 3);
    woff = (unsigned)(lrow * ldw + lc * 8) * 2u;
    xoff = (unsigned)(lrow * ldx + lc * 8) * 2u;
    const unsigned off0 = ((unsigned)(h ^ ((r >> 2) & 3))) * 16u;
    a0 = (unsigned)(((wave >> 1) * 64 + r) * 64) + off0;
    b0 = 8192u + (unsigned)(((wave & 1) * 32 * NTI + r) * 64) + off0;
  }
  const char* Wb = (const char*)W; const char* Xb = (const char*)X;
  const unsigned w64 = (unsigned)(64 * ldw) * 2u, x64 = (unsigned)(64 * ldx) * 2u;
  const int nk = K >> 5;
#define LDSP(p) ((__attribute__((address_space(3))) unsigned*)(p))
#define BUFP(u) ((u) < 2 ? g_stage0 + (u) * SB : g_stage1 + ((u) - 2) * SB)
#define STAGE(u, j) do { const unsigned fill_ = (unsigned)tidx() * 16u; const unsigned kb_ = (unsigned)(j) << 6; \
    _Pragma("unroll") for (int i_ = 0; i_ < 2; ++i_) __builtin_amdgcn_global_load_lds((const unsigned*)(Wb + (woff + i_ * w64 + kb_)), LDSP(BUFP(u) + fill_ + i_ * 4096), 16, 0, 0); \
    _Pragma("unroll") for (int i_ = 0; i_ < NTI; ++i_) __builtin_amdgcn_global_load_lds((const unsigned*)(Xb + (xoff + i_ * x64 + kb_)), LDSP(BUFP(u) + 8192 + fill_ + i_ * 4096), 16, 0, 0); } while (0)
#define DSR(dst, addr, off) asm volatile("ds_read_b128 %0, %1 offset:%2" : "=v"(dst) : "v"(addr), "n"(off))
#define COMPUTE(u) do { const unsigned base_ = (unsigned)(size_t)BUFP(u); \
    _Pragma("unroll") for (int ks = 0; ks < 2; ++ks) { \
      f32x4 fa_[2], fb_[3]; \
      const unsigned aa_ = base_ + (ks ? (a0 ^ 32u) : a0), bb_ = base_ + (ks ? (b0 ^ 32u) : b0); \
      DSR(fa_[0], aa_, 0); DSR(fa_[1], aa_, 2048); DSR(fb_[0], bb_, 0); DSR(fb_[1], bb_, 2048); if (NTI == 3) DSR(fb_[2], bb_, 4096); \
      if (NTI == 3) asm volatile("s_waitcnt lgkmcnt(0)" : "+v"(fa_[0]), "+v"(fa_[1]), "+v"(fb_[0]), "+v"(fb_[1]), "+v"(fb_[2])); \
      else asm volatile("s_waitcnt lgkmcnt(0)" : "+v"(fa_[0]), "+v"(fa_[1]), "+v"(fb_[0]), "+v"(fb_[1])); \
      _Pragma("unroll") for (int fi_ = 0; fi_ < 2; ++fi_) _Pragma("unroll") for (int ti_ = 0; ti_ < NTI; ++ti_) \
        acc[fi_][ti_] = MFMA16(__builtin_bit_cast(half8, fa_[fi_]), __builtin_bit_cast(half8, fb_[ti_]), acc[fi_][ti_]); } } while (0)
#define WAITB(j) do { \
    if ((j) + 2 < nk) { if (NP == 5) asm volatile("s_waitcnt vmcnt(10)" ::: "memory"); else asm volatile("s_waitcnt vmcnt(8)" ::: "memory"); } \
    else if ((j) + 1 < nk) { if (NP == 5) asm volatile("s_waitcnt vmcnt(5)" ::: "memory"); else asm volatile("s_waitcnt vmcnt(4)" ::: "memory"); } \
    else asm volatile("s_waitcnt vmcnt(0)" ::: "memory"); \
    asm volatile("s_waitcnt lgkmcnt(0)" ::: "memory"); __builtin_amdgcn_s_barrier(); } while (0)
  __syncthreads();
  STAGE(0, 0); STAGE(1, 1); STAGE(2, 2);
  for (int kt = 0; kt < nk; kt += 4) {
    WAITB(kt);     if (kt + 3 < nk) STAGE(3, kt + 3); COMPUTE(0);
    WAITB(kt + 1); if (kt + 4 < nk) STAGE(0, kt + 4); COMPUTE(1);
    WAITB(kt + 2); if (kt + 5 < nk) STAGE(1, kt + 5); COMPUTE(2);
    WAITB(kt + 3); if (kt + 6 < nk) STAGE(2, kt + 6); COMPUTE(3);
  }
  __syncthreads();
#undef LDSP
#undef BUFP
#undef STAGE
#undef DSR
#undef COMPUTE
#undef WAITB
}

DI int srccol(int n, int mode) {
  if (mode == 0) return n;
  return ((n >> 7) * 64 + ((n >> 6) & 1) * 32 + (n & 31)) + ((n >> 5) & 1) * DFF;
}
struct TDesc { const float* src; h16* dst; int ld, K, n0, k0, mode; };
DI TDesc tdesc(KP p, int it) {
  constexpr int PER_L = 2936;
  const int l = it / PER_L; int idx = it - l * PER_L;
  TDesc d;
  if (idx < 544) { d.src = p.w_in + (size_t)l * DM * INW; d.ld = INW; d.dst = p.wt_in + (size_t)l * INW * DM; d.K = DM; d.n0 = (idx / 16) * 64; d.k0 = (idx % 16) * 64; d.mode = 0; }
  else if (idx < 800) { idx -= 544; d.src = p.w_out + (size_t)l * DM * DM; d.ld = DM; d.dst = p.wt_out + (size_t)l * DM * DM; d.K = DM; d.n0 = (idx / 16) * 64; d.k0 = (idx % 16) * 64; d.mode = 0; }
  else if (idx < 2208) { idx -= 800; d.src = p.ffn_w_in + (size_t)l * DM * 2 * DFF; d.ld = 2 * DFF; d.dst = p.wt_f1 + (size_t)l * 2 * DFF * DM; d.K = DM; d.n0 = (idx / 16) * 64; d.k0 = (idx % 16) * 64; d.mode = 1; }
  else if (idx < 2912) { idx -= 2208; d.src = p.ffn_w_out + (size_t)l * DFF * DM; d.ld = DM; d.dst = p.wt_f2 + (size_t)l * DM * DFF; d.K = DFF; d.n0 = (idx / 44) * 64; d.k0 = (idx % 44) * 64; d.mode = 0; }
  else if (idx < 2920) { idx -= 2912; const int dd = idx / 4; d.src = p.w_up + (size_t)(l * 2 + dd) * 64 * RW; d.ld = RW; d.dst = p.wt_wup + (size_t)(l * 2 + dd) * RW * 64; d.K = 64; d.n0 = (idx % 4) * 64; d.k0 = 0; d.mode = 0; }
  else if (idx < 2928) { idx -= 2920; const int dd = idx / 4; d.src = p.a_up + (size_t)(l * 2 + dd) * 64 * RW; d.ld = RW; d.dst = p.wt_aup + (size_t)(l * 2 + dd) * RW * 64; d.K = 64; d.n0 = (idx % 4) * 64; d.k0 = 0; d.mode = 0; }
  else { idx -= 2928; d.src = p.g_up + (size_t)l * 128 * RW; d.ld = RW; d.dst = p.wt_gup + (size_t)l * RW * 128; d.K = 128; d.n0 = (idx / 2) * 64; d.k0 = (idx % 2) * 64; d.mode = 0; }
  return d;
}
DI void tt_load(const TDesc& d, float (&v)[16]) {
  const int tid = tidx(), j = tid & 63, kq = tid >> 6;
  const float* sp = d.src + (size_t)(d.k0 + kq) * d.ld + srccol(d.n0 + j, d.mode);
#pragma unroll
  for (int i = 0; i < 16; ++i) v[i] = sp[(size_t)(i * 4) * d.ld];
}
DI void tt_store(const TDesc& d, const float (&v)[16], char* smem) {
  float* t = (float*)smem;
  const int tid = tidx(), j = tid & 63, kq = tid >> 6;
#pragma unroll
  for (int i = 0; i < 16; ++i) t[j * 65 + i * 4 + kq] = v[i];
  __syncthreads();
  const int row = tid >> 2, seg = tid & 3;
  half8 v0, v1;
#pragma unroll
  for (int i = 0; i < 8; ++i) { v0[i] = (h16)t[row * 65 + seg * 16 + i]; v1[i] = (h16)t[row * 65 + seg * 16 + 8 + i]; }
  h16* dp = d.dst + (size_t)(d.n0 + row) * d.K + d.k0 + seg * 16;
  *(half8*)dp = v0; *(half8*)(dp + 8) = v1;
  __syncthreads();
}

DI void phase_prep(KP p, char* smem) {
  const int tid = tidx(), G = gridDim.x;
  {
    constexpr int TOTAL = NL * 2936;
    int it = blockIdx.x;
    if (it < TOTAL) {
      TDesc d = tdesc(p, it);
      float v[16];
      tt_load(d, v);
      for (;;) {
        const int nit = it + G;
        const bool has = nit < TOTAL;
        TDesc nd = d; float nv[16];
#pragma unroll
        for (int i = 0; i < 16; ++i) nv[i] = 0.f;
        if (has) { nd = tdesc(p, nit); tt_load(nd, nv); }
        asm volatile("" ::: "memory");
        tt_store(d, v, smem);
        if (!has) break;
        d = nd; it = nit;
#pragma unroll
        for (int i = 0; i < 16; ++i) v[i] = nv[i];
      }
    }
  }
  {
    float* sv = (float*)smem;
    float* red = sv + 5 * 1024;
    for (int it = blockIdx.x; it < NL * 96; it += G) {
      const int l = it / 96, cgp = it % 96;
      for (int i = tid; i < 5 * 1024; i += 256) {
        const int s = i >> 10, k = i & 1023;
        const float v = (s == 0) ? p.c_ctx[k] : p.c[(s - 1) * 1024 + k];
        sv[i] = v * sigmoidf_(v);
      }
      __syncthreads();
      const int col = cgp * 64 + (tid & 63), kq = tid >> 6;
      float a0 = 0, a1 = 0, a2 = 0, a3 = 0, a4 = 0;
      const float* w = p.w_ada + (size_t)l * DM * 6144 + col;
#pragma unroll 32
      for (int k = kq * 256; k < kq * 256 + 256; ++k) {
        const float wv = w[(size_t)k * 6144];
        a0 += sv[k] * wv; a1 += sv[1024 + k] * wv; a2 += sv[2048 + k] * wv; a3 += sv[3072 + k] * wv; a4 += sv[4096 + k] * wv;
      }
      float* rp = red + kq * 320 + (tid & 63);
      rp[0] = a0; rp[64] = a1; rp[128] = a2; rp[192] = a3; rp[256] = a4;
      __syncthreads();
      for (int i = tid; i < 320; i += 256) {
        const int s = i >> 6, cc = i & 63;
        const float v = red[i] + red[320 + i] + red[640 + i] + red[960 + i] + p.b_ada[l * 6144 + cgp * 64 + cc];
        p.mod[((size_t)l * 5 + s) * 6144 + cgp * 64 + cc] = v;
      }
      __syncthreads();
    }
  }
  const int gtid = blockIdx.x * 256 + tid, gstride = G * 256;
  for (int i = gtid; i < 4096 * 2048; i += gstride) {
    const int m = i >> 11, t = i & 2047;
    const int idx = ((m & 2047) * t) & 2047;
    const float ang = (float)idx * (1.f / 1024.f);
    p.cs_lat[i] = (h16)((m < 2048) ? cospif(ang) : sinpif(ang));
  }
  for (int i = gtid; i < 512 * 256; i += gstride) {
    const int m = i >> 8, t = i & 255;
    const int idx = ((m & 255) * t) & 255;
    const float ang = (float)idx * (1.f / 128.f);
    p.cs_ctx[i] = (h16)((m < 256) ? cospif(ang) : sinpif(ang));
  }
  for (int i = gtid; i < 128 * 128; i += gstride) {
    const int cp = i >> 7, k = i & 127;
    float v = 0.f;
    if (cp < 64) { const int idx = ((k & 63) * cp) & 63; const float ang = (float)idx * (1.f / 32.f); v = (k < 64) ? cospif(ang) : -sinpif(ang); }
    p.cs64t[i] = (h16)v;
  }
  for (int i = gtid; i < 1024; i += gstride) {
    const int pos = i >> 4, q = i & 15;
    const float inv = powf(10000.f, -(float)q / 16.f);
    const float ang = (float)pos * inv;
    p.rope[i] = cosf(ang); p.rope[1024 + i] = sinf(ang);
  }
  for (int i0 = gtid; i0 < 4 * NL * 512 * 128; i0 += 4 * gstride) {
    float kv[4], vv[4];
#pragma unroll
    for (int u = 0; u < 4; ++u) { const int i = i0 + u * gstride; const bool ok = i < 4 * NL * 512 * 128; kv[u] = ok ? p.cache_k[i] : 0.f; vv[u] = ok ? p.cache_v[i] : 0.f; }
#pragma unroll
    for (int u = 0; u < 4; ++u) {
      const int i = i0 + u * gstride;
      if (i < 4 * NL * 512 * 128) {
        const int d = i & 63, kvh = (i >> 6) & 1, pos = (i >> 7) & 511, bl = i >> 16;
        p.ck[(((size_t)bl * 2 + kvh) * 512 + pos) * 64 + d] = (h16)kv[u];
        p.cvt[(((size_t)bl * 2 + kvh) * 64 + d) * 512 + pos] = (h16)vv[u];
      }
    }
  }
  for (int i = gtid; i < 2 * NL * NTOK; i += gstride) p.ssq[i] = 0.f;
  {
    constexpr int NV = NTOK * DM / 4, NP = NCTX * DM / 4;
    for (int i0 = gtid; i0 < NV; i0 += 8 * gstride) {
      f32x4 v[8];
#pragma unroll
      for (int u = 0; u < 8; ++u) { const int i = i0 + u * gstride; v[u] = (i < NV) ? ((i < NP) ? ((const f32x4*)p.x_prompt)[i] : ((const f32x4*)p.x_sample)[i - NP]) : (f32x4){0.f, 0.f, 0.f, 0.f}; }
#pragma unroll
      for (int u = 0; u < 8; ++u) { const int i = i0 + u * gstride; if (i < NV) ((f32x4*)p.x)[i] = v[u]; }
    }
  }
}

DI void phase_pre(KP p) {
  const int lane = tidx() & 63, wave = tidx() >> 6;
  const int gw = blockIdx.x * 4 + wave, nw = gridDim.x * 4;
  for (int tok = gw; tok < NTOK; tok += nw) {
    int seq0, T, t, ms; tokinfo(tok, seq0, T, t, ms);
    const float* mod = p.mod + (size_t)ms * 6144;
    const float* xr = p.x + (size_t)tok * DM;
    float ss = 0.f;
#pragma unroll
    for (int i = 0; i < 4; ++i) {
      const int c = i * 256 + lane * 4;
      const f32x4 v = *(const f32x4*)(xr + c), gv = *(const f32x4*)(p.norm_mix_g + c), sc = *(const f32x4*)(mod + 1024 + c);
      ss += v[0] * v[0] + v[1] * v[1] + v[2] * v[2] + v[3] * v[3];
      *(half4*)(p.hm + (size_t)tok * DM + c) = to_half4(v[0] * gv[0] * (1.f + sc[0]), v[1] * gv[1] * (1.f + sc[1]), v[2] * gv[2] * (1.f + sc[2]), v[3] * gv[3] * (1.f + sc[3]));
    }
    ss = reduce64(ss);
    if (lane == 0) p.ssq[tok] = ss;
  }
  constexpr int RPL = INW + 2 * DFF;
  for (int row = gw; row < NL * RPL; row += nw) {
    const int l = row / RPL, rr = row - l * RPL;
    const bool ffn = rr >= INW;
    const int n = ffn ? rr - INW : rr;
    const h16* wrow = (ffn ? p.wt_f1 + (size_t)l * 2 * DFF * DM : p.wt_in + (size_t)l * INW * DM) + (size_t)n * DM + lane * 16;
    const half8 w0 = *(const half8*)wrow, w1 = *(const half8*)(wrow + 8);
    float wv[16];
#pragma unroll
    for (int j = 0; j < 8; ++j) { wv[j] = (float)w0[j]; wv[8 + j] = (float)w1[j]; }
    float* dst = (ffn ? p.bias_f1 + (size_t)l * 5 * 2 * DFF : p.bias_in + (size_t)l * 5 * INW) + n;
#pragma unroll
    for (int sidx = 0; sidx < 5; ++sidx) {
      const float* sh = p.mod + ((size_t)l * 5 + sidx) * 6144 + (ffn ? 3 * 1024 : 0) + lane * 16;
      float d = 0.f;
#pragma unroll
      for (int q = 0; q < 4; ++q) { const f32x4 sv = *(const f32x4*)(sh + 4 * q); d += sv[0] * wv[4 * q] + sv[1] * wv[4 * q + 1] + sv[2] * wv[4 * q + 2] + sv[3] * wv[4 * q + 3]; }
      d = reduce64(d);
      if (lane == 0) dst[(size_t)sidx * (ffn ? 2 * DFF : INW)] = d;
    }
  }
}
DI void phase_final_norm(KP p) {
  const int lane = tidx() & 63, wave = tidx() >> 6;
  for (int tok = blockIdx.x * 4 + wave; tok < NTOK; tok += gridDim.x * 4) {
    float* xr = p.x + (size_t)tok * DM;
    f32x4 v[4]; float ss = 0.f;
#pragma unroll
    for (int i = 0; i < 4; ++i) { v[i] = *(const f32x4*)(xr + i * 256 + lane * 4); ss += v[i][0] * v[i][0] + v[i][1] * v[i][1] + v[i][2] * v[i][2] + v[i][3] * v[i][3]; }
    ss = reduce64(ss);
    const float rstd = rsqrtf(ss * (1.f / 1024.f) + 1e-6f);
#pragma unroll
    for (int i = 0; i < 4; ++i) {
      const int c = i * 256 + lane * 4;
      const f32x4 gv = *(const f32x4*)(p.norm_final_g + c);
      f32x4 o;
#pragma unroll
      for (int j = 0; j < 4; ++j) o[j] = v[i][j] * rstd * gv[j];
      *(f32x4*)(xr + c) = o;
    }
  }
}

DI bool xcd_tile(int k, int nft, int& tt, int& ft, int tpx = 12) {
  const int x = blockIdx.x & 7, j = blockIdx.x >> 3, J = gridDim.x >> 3;
  const int i = j + J * k;
  if (i >= tpx * nft) return false;
  tt = tpx * x + i % tpx; ft = i / tpx;
  return true;
}
DI void phase_inproj(KP p, int l, char* smem) {
  const int lane = tidx() & 63, wave = tidx() >> 6, wf = wave >> 1, wt = wave & 1, r = lane & 31, h = lane >> 5;
  const h16* W = p.wt_in + (size_t)l * INW * DM;
  int tt, ft, tt2 = 0, ft2 = 0;
  bool have = xcd_tile(0, 17, tt, ft), pre = false;
  for (int k = 0; have; ++k, tt = tt2, ft = ft2) {
    const bool have2 = xcd_tile(k + 1, 17, tt2, ft2);
    f32x16 acc[2][2];
    gemm_ring<2>(W + (size_t)ft * 128 * DM, DM, p.hm + (size_t)tt * 128 * DM, DM, DM, acc);
    pre = have2; have = have2;
    int msv[2]; float rq[2];
#pragma unroll
    for (int ti = 0; ti < 2; ++ti) {
      const int tok_ = tt * 128 + wt * 64 + ti * 32 + r;
      int sq_, T_, t_; tokinfo(tok_, sq_, T_, t_, msv[ti]);
      rq[ti] = p.ssq[(size_t)l * NTOK + tok_];
    }
    const bool uni = __all((msv[0] == msv[1]) && (msv[0] == __builtin_amdgcn_readfirstlane(msv[0])));
    f32x4 bi[2][4];
#pragma unroll
    for (int fi = 0; fi < 2; ++fi)
#pragma unroll
      for (int g = 0; g < 4; ++g) bi[fi][g] = *(const f32x4*)(p.bias_in + ((size_t)l * 5 + msv[0]) * INW + ft * 128 + wf * 64 + fi * 32 + 4 * h + 8 * g);
    asm volatile("" ::: "memory");

#pragma unroll
    for (int fi = 0; fi < 2; ++fi)
#pragma unroll
      for (int ti = 0; ti < 2; ++ti) {
        const int nb = ft * 128 + wf * 64 + fi * 32;
        const int tok = tt * 128 + wt * 64 + ti * 32 + r;
        int seq0, T, t, ms; tokinfo(tok, seq0, T, t, ms);
        const bool lat = tok >= NCTX;
        f32x16 a = acc[fi][ti];
        {
          const float rstd = rsqrtf(rq[ti] * (1.f / 1024.f) + 1e-6f);
          const float* bp = p.bias_in + ((size_t)l * 5 + ms) * INW + nb + 4 * h;
#pragma unroll
          for (int g = 0; g < 4; ++g) { const f32x4 bv = uni ? bi[fi][g] : *(const f32x4*)(bp + 8 * g);
#pragma unroll
            for (int j = 0; j < 4; ++j) a[4 * g + j] = a[4 * g + j] * rstd + bv[j]; }
        }
        if (nb < 640) {
          if (lat) {
            const int pos = (nb & 32) ? (t & 63) : (t >> 6);
#pragma unroll
            for (int i = 0; i < 8; ++i) {
              const int q = (i & 3) + 8 * (i >> 2) + 4 * h;
              const float cs = p.rope[pos * 16 + q], sn = p.rope[1024 + pos * 16 + q];
              const float x1 = a[i], x2 = a[i + 8];
              a[i] = x1 * cs - x2 * sn; a[i + 8] = x2 * cs + x1 * sn;
            }
          }
          if (nb < 512) {
#pragma unroll
            for (int g = 0; g < 4; ++g)
              *(half4*)(p.qh + (size_t)tok * 512 + nb + 4 * h + 8 * g) = to_half4(a[4 * g] * 0.125f, a[4 * g + 1] * 0.125f, a[4 * g + 2] * 0.125f, a[4 * g + 3] * 0.125f);
          } else {
            const int kvh = (nb - 512) >> 6;
#pragma unroll
            for (int g = 0; g < 4; ++g) {
              *(half4*)(p.kh + ((size_t)kvh * NTOK + tok) * 64 + (nb & 63) + 4 * h + 8 * g) = to_half4(a[4 * g], a[4 * g + 1], a[4 * g + 2], a[4 * g + 3]);
              if (!lat) {
                f32x4 o = {a[4 * g], a[4 * g + 1], a[4 * g + 2], a[4 * g + 3]};
                *(f32x4*)(p.out_k + (((size_t)(tok >> 8) * NL + l) * 256 + t) * 128 + (nb - 512) + 4 * h + 8 * g) = o;
              }
            }
          }
        } else if (nb < 768) {
          const int c0 = nb - 640;
#pragma unroll
          for (int g = 0; g < 4; ++g) {
#pragma unroll
            for (int j = 0; j < 4; ++j) p.vt[(size_t)seq0 * 128 + (size_t)(c0 + 4 * h + 8 * g + j) * T + t] = (h16)a[4 * g + j];
            if (!lat) {
              f32x4 o = {a[4 * g], a[4 * g + 1], a[4 * g + 2], a[4 * g + 3]};
              *(f32x4*)(p.out_v + (((size_t)(tok >> 8) * NL + l) * 256 + t) * 128 + c0 + 4 * h + 8 * g) = o;
            }
          }
        } else if (nb < 1920) {
#pragma unroll
          for (int g = 0; g < 4; ++g) {
            f32x4 o = {a[4 * g], a[4 * g + 1], a[4 * g + 2], a[4 * g + 3]};
            *(f32x4*)(p.ur + (size_t)tok * 1152 + (nb - 768) + 4 * h + 8 * g) = o;
          }
        } else {
          const int c0 = nb - 1920;
#pragma unroll
          for (int g = 0; g < 4; ++g)
#pragma unroll
            for (int j = 0; j < 4; ++j) p.zt[(size_t)seq0 * 256 + (size_t)(c0 + 4 * h + 8 * g + j) * T + t] = (h16)a[4 * g + j];
        }
      }
  }
}

DI void phase_gemm_residual(KP p, int l, const h16* W, const h16* X, int K, int gate_idx, h16* xg_out, float* ssq_out, const float* ng, int nl, int sc_idx, char* smem) {
  const int lane = tidx() & 63, wave = tidx() >> 6, wf = wave >> 1, wt = wave & 1, r = lane & 31, h = lane >> 5;
  int tt, ft, tt2 = 0, ft2 = 0;
  bool have = xcd_tile(0, 8, tt, ft, 8), pre = false;
  for (int k = 0; have; ++k, tt = tt2, ft = ft2) {
    const bool have2 = xcd_tile(k + 1, 8, tt2, ft2, 8);
    f32x16 acc[2][3];
    gemm_ring<3>(W + (size_t)ft * 128 * K, K, X + (size_t)tt * 192 * K, K, K, acc);
    pre = have2; have = have2;
#pragma unroll
    for (int ti = 0; ti < 3; ++ti) {
      const int tok = tt * 192 + wt * 96 + ti * 32 + r;
      int seq0, T, t, ms; tokinfo(tok, seq0, T, t, ms);
      const float* gate = p.mod + ((size_t)l * 5 + ms) * 6144 + gate_idx * 1024;
      const float* nsc = p.mod + ((size_t)nl * 5 + ms) * 6144 + sc_idx * 1024;
      float ss = 0.f;
#pragma unroll
      for (int fi = 0; fi < 2; ++fi) {
        const int nb = ft * 128 + wf * 64 + fi * 32 + 4 * h;
#pragma unroll
        for (int g = 0; g < 4; ++g) {
          const int n = nb + 8 * g;
          const f32x4 gv = *(const f32x4*)(gate + n);
          f32x4* xp = (f32x4*)(p.x + (size_t)tok * DM + n);
          f32x4 xv = *xp;
#pragma unroll
          for (int j = 0; j < 4; ++j) xv[j] += gv[j] * acc[fi][ti][4 * g + j];
          *xp = xv;
          if (xg_out) {
            const f32x4 g2 = *(const f32x4*)(ng + n), s2 = *(const f32x4*)(nsc + n);
            ss += xv[0] * xv[0] + xv[1] * xv[1] + xv[2] * xv[2] + xv[3] * xv[3];
            *(half4*)(xg_out + (size_t)tok * DM + n) = to_half4(xv[0] * g2[0] * (1.f + s2[0]), xv[1] * g2[1] * (1.f + s2[1]), xv[2] * g2[2] * (1.f + s2[2]), xv[3] * g2[3] * (1.f + s2[3]));
          }
        }
      }
      if (xg_out) {
        ss += __shfl_xor(ss, 32, 64);
        if (h == 0) __hip_atomic_fetch_add(ssq_out + tok, ss, __ATOMIC_RELAXED, __HIP_MEMORY_SCOPE_AGENT);
      }
    }
  }
}

DI void phase_ffn_in(KP p, int l, char* smem) {
  const int lane = tidx() & 63, wave = tidx() >> 6, wf = wave >> 1, wt = wave & 1, r = lane & 31, h = lane >> 5;
  const h16* W = p.wt_f1 + (size_t)l * 2 * DFF * DM;
  int tt, ft, tt2 = 0, ft2 = 0;
  bool have = xcd_tile(0, 44, tt, ft, 8), pre = false;
  for (int k = 0; have; ++k, tt = tt2, ft = ft2) {
    const bool have2 = xcd_tile(k + 1, 44, tt2, ft2, 8);
    f32x16 acc[2][3];
    gemm_ring<3>(W + (size_t)ft * 128 * DM, DM, p.hm2 + (size_t)tt * 192 * DM, DM, DM, acc);
    pre = have2; have = have2;
    int msv[3]; float rstd[3];
#pragma unroll
    for (int ti = 0; ti < 3; ++ti) {
      const int tok = tt * 192 + wt * 96 + ti * 32 + r;
      int seq0, T, t; tokinfo(tok, seq0, T, t, msv[ti]);
      rstd[ti] = p.ssq[(size_t)(NL + l) * NTOK + tok];
    }
    const bool uni = __all((msv[0] == msv[1]) && (msv[1] == msv[2]) && (msv[0] == __builtin_amdgcn_readfirstlane(msv[0])));
    const float* bp0 = p.bias_f1 + ((size_t)l * 5 + msv[0]) * 2 * DFF + ft * 128 + wf * 64 + 4 * h;
    f32x4 bg[4], bu[4];
#pragma unroll
    for (int g = 0; g < 4; ++g) { bg[g] = *(const f32x4*)(bp0 + 8 * g); bu[g] = *(const f32x4*)(bp0 + 32 + 8 * g); }
    asm volatile("" ::: "memory");

    char* tw_ = g_stage1 + wave * 7680;
#pragma unroll
    for (int ti = 0; ti < 3; ++ti) {
      const float rs = rsqrtf(rstd[ti] * (1.f / 1024.f) + 1e-6f);
      if (!uni) {
        const float* bp = p.bias_f1 + ((size_t)l * 5 + msv[ti]) * 2 * DFF + ft * 128 + wf * 64 + 4 * h;
#pragma unroll
        for (int g = 0; g < 4; ++g) { bg[g] = *(const f32x4*)(bp + 8 * g); bu[g] = *(const f32x4*)(bp + 32 + 8 * g); }
      }
#pragma unroll
      for (int g = 0; g < 4; ++g) {
        float o[4];
#pragma unroll
        for (int j = 0; j < 4; ++j) { const float gt = acc[0][ti][4 * g + j] * rs + bg[g][j], up = acc[1][ti][4 * g + j] * rs + bu[g][j]; o[j] = gt * sigmoidf_(gt) * up; }
        *(half4*)(tw_ + ti * 2560 + r * 80 + (4 * h + 8 * g) * 2) = to_half4(o[0], o[1], o[2], o[3]);
      }
    }
    asm volatile("" ::: "memory");
    __builtin_amdgcn_wave_barrier();
#pragma unroll
    for (int ti = 0; ti < 3; ++ti)
#pragma unroll
      for (int q = 0; q < 2; ++q) {
        const int tl = q * 16 + (lane >> 2), ch = lane & 3;
        const uint4 v = *(const uint4*)(tw_ + ti * 2560 + tl * 80 + ch * 16);
        *(uint4*)(p.act + (size_t)(tt * 192 + wt * 96 + ti * 32 + tl) * DFF + ft * 64 + wf * 32 + ch * 8) = v;
      }
    asm volatile("" ::: "memory");
    __builtin_amdgcn_wave_barrier();
  }
}

DI void attn_tiles(const h16* Kb, const h16* Vtb, int ldv, int kt_begin, int kt_end, bool masked, int q0, const half8 (&qf)[4],
                   float& m, float& lsum, f32x16& o0, f32x16& o1, int r, int h) {
  half8 kc0, kc1, kc2, kc3;
  {
    const h16* kp = Kb + (size_t)(kt_begin * 32 + r) * 64 + h * 8;
    kc0 = *(const half8*)kp; kc1 = *(const half8*)(kp + 16); kc2 = *(const half8*)(kp + 32); kc3 = *(const half8*)(kp + 48);
  }
  for (int kt = kt_begin; kt < kt_end; ++kt) {
    const int key0 = kt * 32;
    const h16* vp0 = Vtb + (size_t)r * ldv + key0 + 4 * h;
    const h16* vp1 = vp0 + (size_t)32 * ldv;
    const half4 v00l = *(const half4*)vp0, v00h = *(const half4*)(vp0 + 8), v01l = *(const half4*)(vp0 + 16), v01h = *(const half4*)(vp0 + 24);
    const half4 v10l = *(const half4*)vp1, v10h = *(const half4*)(vp1 + 8), v11l = *(const half4*)(vp1 + 16), v11h = *(const half4*)(vp1 + 24);
    half8 kn0 = kc0, kn1 = kc1, kn2 = kc2, kn3 = kc3;
    if (kt + 1 < kt_end) {
      const h16* kp = Kb + (size_t)(key0 + 32 + r) * 64 + h * 8;
      kn0 = *(const half8*)kp; kn1 = *(const half8*)(kp + 16); kn2 = *(const half8*)(kp + 32); kn3 = *(const half8*)(kp + 48);
    }
    asm volatile("" ::: "memory");
    f32x16 x;
#pragma unroll
    for (int i = 0; i < 16; ++i) x[i] = 0.f;
    x = MFMA16(kc0, qf[0], x); x = MFMA16(kc1, qf[1], x); x = MFMA16(kc2, qf[2], x); x = MFMA16(kc3, qf[3], x);
    if (masked) {
      const int qpos = q0 + r;
#pragma unroll
      for (int i = 0; i < 16; ++i) {
        const int key = key0 + (i & 3) + 8 * (i >> 2) + 4 * h;
        const int d = key - qpos;
        if (d > 128 || d < -128) x[i] = -1e30f;
      }
    }
    float tmax = x[0];
#pragma unroll
    for (int i = 1; i < 16; ++i) tmax = fmaxf(tmax, x[i]);
    tmax = fmaxf(tmax, __shfl_xor(tmax, 32, 64));
    const float mnew = fmaxf(m, tmax);
    const float alpha = __expf(m - mnew);
    m = mnew;
    float ps = 0.f;
#pragma unroll
    for (int i = 0; i < 16; ++i) { x[i] = __expf(x[i] - mnew); ps += x[i]; }
    lsum = lsum * alpha + ps;
#pragma unroll
    for (int i = 0; i < 16; ++i) { o0[i] *= alpha; o1[i] *= alpha; }
    half8 pf0, pf1;
#pragma unroll
    for (int j = 0; j < 8; ++j) { pf0[j] = (h16)x[j]; pf1[j] = (h16)x[8 + j]; }
    o0 = MFMA16(__builtin_shufflevector(v00l, v00h, 0, 1, 2, 3, 4, 5, 6, 7), pf0, o0);
    o1 = MFMA16(__builtin_shufflevector(v10l, v10h, 0, 1, 2, 3, 4, 5, 6, 7), pf0, o1);
    o0 = MFMA16(__builtin_shufflevector(v01l, v01h, 0, 1, 2, 3, 4, 5, 6, 7), pf1, o0);
    o1 = MFMA16(__builtin_shufflevector(v11l, v11h, 0, 1, 2, 3, 4, 5, 6, 7), pf1, o1);
    kc0 = kn0; kc1 = kn1; kc2 = kn2; kc3 = kn3;
  }
}
DI void attn_item(KP p, int l, int bitem) {
  const int lane = tidx() & 63, wave = tidx() >> 6, r = lane & 31, h = lane >> 5;
  const bool lat = bitem < 512;
  int b, qt, kvh;
  if (lat) { kvh = bitem & 1; qt = (bitem >> 1) & 63; b = bitem >> 7; }
  else { const int c = bitem - 512; kvh = c & 1; qt = (c >> 1) & 7; b = c >> 4; }
  const int head = kvh * 4 + wave;
  const int T = lat ? 2048 : 256, tok0 = lat ? NCTX + b * 2048 : b * 256, q0 = qt * 32;
  half8 qf[4];
#pragma unroll
  for (int s = 0; s < 4; ++s) qf[s] = *(const half8*)(p.qh + (size_t)(tok0 + q0 + r) * 512 + head * 64 + s * 16 + h * 8);
  float m = p.attn_sink[l * 8 + head], lsum = (h == 0) ? 1.f : 0.f;
  f32x16 o0, o1;
#pragma unroll
  for (int i = 0; i < 16; ++i) { o0[i] = 0.f; o1[i] = 0.f; }
  const h16* Kb = p.kh + ((size_t)kvh * NTOK + tok0) * 64;
  const h16* Vtb = p.vt + (size_t)tok0 * 128 + (size_t)kvh * 64 * T;
  if (lat) {
    int kb = (q0 - 128) >> 5; if (kb < 0) kb = 0;
    int ke = ((q0 + 159) >> 5) + 1; if (ke > 64) ke = 64;
    attn_tiles(Kb, Vtb, T, kb, ke, true, q0, qf, m, lsum, o0, o1, r, h);
    const size_t cb = ((size_t)(b * NL + l) * 2 + kvh);
    attn_tiles(p.ck + cb * 512 * 64, p.cvt + cb * 64 * 512, 512, 0, 16, false, q0, qf, m, lsum, o0, o1, r, h);
  } else {
    attn_tiles(Kb, Vtb, T, 0, 8, false, q0, qf, m, lsum, o0, o1, r, h);
  }
  const float ltot = lsum + __shfl_xor(lsum, 32, 64);
  const float inv = 1.f / ltot;
  h16* op = p.hm + (size_t)(tok0 + q0 + r) * DM + head * 64 + 4 * h;
#pragma unroll
  for (int g = 0; g < 4; ++g) {
    *(half4*)(op + 8 * g) = to_half4(o0[4 * g] * inv, o0[4 * g + 1] * inv, o0[4 * g + 2] * inv, o0[4 * g + 3] * inv);
    *(half4*)(op + 32 + 8 * g) = to_half4(o1[4 * g] * inv, o1[4 * g + 1] * inv, o1[4 * g + 2] * inv, o1[4 * g + 3] * inv);
  }
}

template <bool LAT> DI void fourierA_item(KP p, int item, char* smem) {
  const int lane = tidx() & 63, wave = tidx() >> 6, wf = wave >> 1, wt = wave & 1, r = lane & 31, h = lane >> 5;
  constexpr int T = LAT ? 2048 : 256;
  int tok0, mt, ft; const h16* tab;
  if (LAT) { const int seq = item >> 6; mt = (item >> 1) & 31; ft = item & 1; tok0 = NCTX + seq * 2048; tab = p.cs_lat; }
  else { const int c = item - 256; const int seq = c >> 3; mt = (c >> 1) & 3; ft = c & 1; tok0 = seq * 256; tab = p.cs_ctx; }
  f32x16 acc[2][2];
  gemm_mainloop<2>(p.zt + (size_t)tok0 * 256 + (size_t)ft * 128 * T, T, tab + (size_t)mt * 128 * T, T, T, smem, acc);
#pragma unroll
  for (int fi = 0; fi < 2; ++fi)
#pragma unroll
    for (int ti = 0; ti < 2; ++ti) {
      const int n = ft * 128 + wf * 64 + fi * 32 + 4 * h;
      const int mm = mt * 128 + wt * 64 + ti * 32 + r;
      const int tp = mm & (T - 1), sc = (mm >= T) ? 1 : 0;
      h16* dst = p.pq + (size_t)(tok0 + tp) * 512 + (n >> 6) * 128 + sc * 64 + (n & 63);
#pragma unroll
      for (int g = 0; g < 4; ++g) *(half4*)(dst + 8 * g) = to_half4(acc[fi][ti][4 * g], acc[fi][ti][4 * g + 1], acc[fi][ti][4 * g + 2], acc[fi][ti][4 * g + 3]);
    }
}

DI void rwkv_prep_token(KP p, int l, int tok, int lane_) {
  const int lane = tidx() & 63;
  int seq0, T, t, ms; tokinfo(tok, seq0, T, t, ms);
  const bool hp = t > 0, hn = t < T - 1;
  const float* u = p.ur + (size_t)tok * 1152;
  const float* sw = p.shift_w + (size_t)l * 3 * 1152;
  f32x4 sec[5];
#pragma unroll
  for (int i = 0; i < 5; ++i) {
    const int c = i * 256 + lane * 4;
    f32x4 o = {0.f, 0.f, 0.f, 0.f};
    if (i < 4 || lane < 32) {
      const f32x4 w1 = *(const f32x4*)(sw + 1152 + c);
      o = *(const f32x4*)(u + c) * w1;
      if (hp) o += *(const f32x4*)(u - 1152 + c) * *(const f32x4*)(sw + c);
      if (hn) o += *(const f32x4*)(u + 1152 + c) * *(const f32x4*)(sw + 2304 + c);
    }
    sec[i] = o;
  }
  const int c = lane * 4;
  const f32x4 r4 = sec[0], k4 = sec[1], v4 = sec[2];
  float* shp = p.sh + (size_t)tok * 768 + (lane >> 4) * 192 + (lane & 15) * 4;
  *(f32x4*)(shp + 64) = r4;
  *(f32x4*)(p.kx + (size_t)tok * RW + c) = k4;
  *(f32x4*)(shp + 128) = v4;
  const f32x4 kkw = *(const f32x4*)(p.k_k + l * RW + c);
  f32x4 kk = k4 * kkw;
  float ss = kk[0] * kk[0] + kk[1] * kk[1] + kk[2] * kk[2] + kk[3] * kk[3];
  ss = reduce16(ss);
  const float rn = rsqrtf(ss + 1e-12f);
  kk = kk * rn;
  *(f32x4*)shp = kk;
  const f32x4 rk = *(const f32x4*)(p.r_k + l * RW + c);
  float bs = r4[0] * k4[0] * rk[0] + r4[1] * k4[1] * rk[1] + r4[2] * k4[2] * rk[2] + r4[3] * k4[3] * rk[3];
  bs = reduce16(bs);
  if ((lane & 15) == 0) p.bonus[(size_t)tok * 4 + (lane >> 4)] = bs;
  if (lane < 32) {
    const f32x4 gd = sec[3];
    *(half4*)(p.sg + (size_t)tok * 128 + lane * 4) = to_half4(sigmoidf_(gd[0]), sigmoidf_(gd[1]), sigmoidf_(gd[2]), sigmoidf_(gd[3]));
    const f32x4 ad = sec[4];
    *(half4*)(p.ad + (size_t)tok * 128 + lane * 4) = to_half4(ad[0], ad[1], ad[2], ad[3]);
  } else {
    const f32x4 wd = sec[3];
    *(half4*)(p.tw + (size_t)tok * 128 + (lane - 32) * 4) = to_half4(tanhf(wd[0]), tanhf(wd[1]), tanhf(wd[2]), tanhf(wd[3]));
  }
}

DI int first_item(int off) { const int G = gridDim.x; return (int)((blockIdx.x + G - (off % G)) % G); }
DI void phase_mix_a(KP p, int l, char* smem) {
  const int lane = tidx() & 63, wave = tidx() >> 6, G = gridDim.x;
  for (int it = blockIdx.x; it < 768; it += G) {
    const int base = it * 16;
    for (int j = 0; j < 4; ++j) rwkv_prep_token(p, l, base + wave * 4 + j, lane);
  }
}

template <int KIND> DI void lowrank_tile(KP p, int l, int rem, char* smem) {
  const int lane = tidx() & 63, wave = tidx() >> 6, wf = wave >> 1, wt = wave & 1, r = lane & 31, h = lane >> 5;
  const size_t PL = (size_t)NTOK * RW;
  const int ft = rem & 1, tt = rem >> 1;
  const h16 *W, *X; constexpr int K = (KIND == 4) ? 128 : 64;
  if (KIND < 2) { W = p.wt_wup + (size_t)(l * 2 + KIND) * RW * 64; X = p.tw + KIND * 64; }
  else if (KIND < 4) { W = p.wt_aup + (size_t)(l * 2 + KIND - 2) * RW * 64; X = p.ad + (KIND - 2) * 64; }
  else { W = p.wt_gup + (size_t)l * RW * 128; X = p.sg; }
  f32x16 acc[2][2];
  gemm_mainloop<2>(W + (size_t)ft * 128 * K, K, X + (size_t)tt * 128 * 128, 128, K, smem, acc);
#pragma unroll
  for (int fi = 0; fi < 2; ++fi)
#pragma unroll
    for (int ti = 0; ti < 2; ++ti) {
      const int nb = ft * 128 + wf * 64 + fi * 32 + 4 * h;
      const int tok = tt * 128 + wt * 64 + ti * 32 + r;
#pragma unroll
      for (int g = 0; g < 4; ++g) {
        const int n = nb + 8 * g;
        const size_t off = (size_t)tok * RW + n;
        f32x4 a = {acc[fi][ti][4 * g], acc[fi][ti][4 * g + 1], acc[fi][ti][4 * g + 2], acc[fi][ti][4 * g + 3]};
        if (KIND < 2) {
          const f32x4 w0 = *(const f32x4*)(p.w0 + (l * 2 + KIND) * RW + n);
          f32x4 o;
#pragma unroll
          for (int j = 0; j < 4; ++j) o[j] = __expf(-0.6065306597126334f * sigmoidf_(w0[j] + a[j]));
          *(f32x4*)(p.dr + ((size_t)KIND * NTOK + tok) * 768 + (n >> 6) * 192 + (n & 63)) = o;
        } else if (KIND < 4) {
          constexpr int d = KIND - 2;
          const f32x4 a0 = *(const f32x4*)(p.a0 + (l * 2 + d) * RW + n);
          const f32x4 ka = *(const f32x4*)(p.k_a + l * RW + n);
          const f32x4 kk = *(const f32x4*)(p.sh + (size_t)tok * 768 + (n >> 6) * 192 + (n & 63));
          const f32x4 kx = *(const f32x4*)(p.kx + off);
          f32x4 ob, ok;
#pragma unroll
          for (int j = 0; j < 4; ++j) { const float av = sigmoidf_(a0[j] + a[j]); ob[j] = kk[j] * av; ok[j] = kx[j] * (1.f + (av - 1.f) * ka[j]); }
          float* drp = p.dr + ((size_t)d * NTOK + tok) * 768 + (n >> 6) * 192 + (n & 63);
          *(f32x4*)(drp + 64) = ob;
          *(f32x4*)(drp + 128) = ok;
        } else {
          *(f32x4*)(p.gg + off) = a;
        }
      }
    }
}
DI void fourierB_tile(KP p, int c, char* smem) {
  const int lane = tidx() & 63, wave = tidx() >> 6, wf = wave >> 1, wt = wave & 1, r = lane & 31, h = lane >> 5;
  const int g4 = c & 3, tt = c >> 2;
  f32x16 acc[2][2];
  gemm_mainloop<2>(p.cs64t, 128, p.pq + (size_t)tt * 128 * 512 + g4 * 128, 512, 128, smem, acc);
  if (wf == 0) {
#pragma unroll
    for (int fi = 0; fi < 2; ++fi)
#pragma unroll
      for (int ti = 0; ti < 2; ++ti) {
        const int n = fi * 32 + 4 * h;
        const int tok = tt * 128 + wt * 64 + ti * 32 + r;
        const float sc = (tok < NCTX) ? (1.f / 128.f) : 0.0027621358640099515f;
        h16* dst = p.hm + (size_t)tok * DM + 768 + g4 * 64 + n;
#pragma unroll
        for (int g = 0; g < 4; ++g)
          *(half4*)(dst + 8 * g) = to_half4(acc[fi][ti][4 * g] * sc, acc[fi][ti][4 * g + 1] * sc, acc[fi][ti][4 * g + 2] * sc, acc[fi][ti][4 * g + 3] * sc);
      }
  }
}
DI void phase_mix_b(KP p, int l, char* smem) {
  const int G = gridDim.x;
  for (int it = first_item(0); it < 192; it += G) lowrank_tile<0>(p, l, it, smem);
  for (int it = first_item(192); it < 192; it += G) lowrank_tile<1>(p, l, it, smem);
  for (int it = first_item(384); it < 192; it += G) lowrank_tile<2>(p, l, it, smem);
  for (int it = first_item(576); it < 192; it += G) lowrank_tile<3>(p, l, it, smem);
  for (int it = first_item(768); it < 192; it += G) lowrank_tile<4>(p, l, it, smem);
}

DI void scan_block_task(KP p, int l, bool lat, int unit, int quarter, char* smem) {
  const size_t PL = (size_t)NTOK * RW;
  const int tid = tidx(), lane = tid & 63, wave = tid >> 6;
  const int dir = unit & 1, hh = (unit >> 1) & 3, b = unit >> 3;
  const int T = lat ? 2048 : 256, tok0 = lat ? NCTX + b * 2048 : b * 256;
  const int rl = lane >> 4, cgp = lane & 15, row = quarter * 16 + wave * 4 + rl, col0 = cgp * 4;
  float* lds = (float*)smem;
  f32x4 S = {0.f, 0.f, 0.f, 0.f};
  if (lat) S = *(const f32x4*)(p.state_rwkv + ((((size_t)(b * NL + l) * 2 + dir) * 4 + hh) * 64 + row) * 64 + col0);
  const float* gbase = p.dr;
  const int sh_off = (int)(p.sh - p.dr);
  const int nch = T >> 3;
  const int tstep = dir ? -1 : 1, tfirst = tok0 + (dir ? T - 1 : 0);
  int goff[3];
#pragma unroll
  for (int i = 0; i < 3; ++i) {
    const int idx = i * 256 + tid, st = idx / 96, within = idx - st * 96;
    goff[i] = tstep * st * 768 + ((within < 48) ? sh_off + hh * 192 + within * 4 : dir * NTOK * 768 + hh * 192 + (within - 48) * 4);
  }
  f32x4 pf[4][3];
  auto issue = [&](f32x4 (&q)[3], int ch) {
    const int cc = (ch < nch) ? ch : nch - 1;
    const int tk0 = (tfirst + tstep * (cc * 8)) * 768;
#pragma unroll
    for (int i = 0; i < 3; ++i) q[i] = *(const f32x4*)(gbase + (tk0 + goff[i]));
  };
  auto stash = [&](const f32x4 (&q)[3], int buf) {
#pragma unroll
    for (int i = 0; i < 3; ++i) *(f32x4*)(lds + buf * 3072 + (i * 256 + tid) * 4) = q[i];
  };
  float* yout = p.yy + (size_t)dir * PL + hh * 64 + row;
  issue(pf[0], 0);
  stash(pf[0], 0);
  issue(pf[0], 1); issue(pf[1], 2); issue(pf[2], 3); issue(pf[3], 4);
  __syncthreads();
  auto chunk = [&](f32x4 (&q)[3], int ch) {
    stash(q, (ch + 1) & 1);
    issue(q, ch + 5);
    asm volatile("" ::: "memory");
    const float* cb = lds + (ch & 1) * 3072;
    float yv = 0.f;
    f32x4 k = *(const f32x4*)(cb + col0), w = *(const f32x4*)(cb + 192 + col0), d = *(const f32x4*)(cb + 320 + col0);
    f32x4 bb = *(const f32x4*)(cb + 256 + col0), rr = *(const f32x4*)(cb + 64 + col0);
    float v = cb[128 + row];
#pragma unroll
    for (int st = 0; st < 8; ++st) {
      const float* np = cb + (st < 7 ? st + 1 : st) * 384;
      const f32x4 nk = *(const f32x4*)(np + col0), nw = *(const f32x4*)(np + 192 + col0), nd = *(const f32x4*)(np + 320 + col0);
      const f32x4 nb = *(const f32x4*)(np + 256 + col0), nr = *(const f32x4*)(np + 64 + col0);
      const float nv = np[128 + row];
      const f32x4 t = S * k;
      float sa = (t[0] + t[1]) + (t[2] + t[3]);
      const f32x4 e = S * w + d * v;
      sa = reduce16(sa);
      S = e - bb * sa;
      const f32x4 u = S * rr;
      float y = (u[0] + u[1]) + (u[2] + u[3]);
      y = reduce16(y);
      yv = (cgp == st) ? y : yv;
      k = nk; w = nw; d = nd; bb = nb; rr = nr; v = nv;
    }
    if (cgp < 8) yout[(size_t)(tfirst + tstep * (ch * 8 + cgp)) * RW] = yv;
    __syncthreads();
  };
  for (int ch = 0; ch < nch; ch += 4) { chunk(pf[0], ch); chunk(pf[1], ch + 1); chunk(pf[2], ch + 2); chunk(pf[3], ch + 3); }
  if (!lat) *(f32x4*)(p.out_s + ((((size_t)(b * NL + l) * 2 + dir) * 4 + hh) * 64 + row) * 64 + col0) = S;
}
DI void phase_scan(KP p, int l, char* smem) {
  const int bx = blockIdx.x, G = gridDim.x;
  if (bx < 128) {
    __builtin_amdgcn_s_setprio(3);
    scan_block_task(p, l, true, (bx & 7) + 8 * (bx >> 5), (bx >> 3) & 3, smem);
    __builtin_amdgcn_s_setprio(0);
  } else {
    const int nb = G - 128, me = bx - 128;
    const int ord = (G == 512) ? (bx >= 256 && bx < 384 ? bx - 256 : (bx < 256 ? bx : bx - 128)) : me;
    for (int c = ord; c < 512; c += nb) { const int j = c >> 3; scan_block_task(p, l, false, (c & 7) + 8 * (j >> 2), j & 3, smem); }
    if (G == 512 && bx >= 256 && bx < 384) return;
    const int nw2 = (G == 512) ? 256 : nb;
    const int me3 = (G == 512) ? (bx < 256 ? bx - 128 : bx - 256) : me;
    for (int it = me3; it < 512; it += nw2) attn_item(p, l, it);
    for (int it = (me3 + nw2 / 2) % nw2; it < 256; it += nw2) fourierA_item<true>(p, it, smem);
    for (int it = me3; it < 256; it += nw2) attn_item(p, l, 512 + it);
    for (int it = me3; it < 128; it += nw2) fourierA_item<false>(p, 256 + it, smem);
  }
}

DI void phase_rwkv_post(KP p, int l) {
  const int lane = tidx() & 63, wave = tidx() >> 6;
  const size_t PL = (size_t)NTOK * RW;
  const int c = lane * 4;
  const f32x4 lg = *(const f32x4*)(p.ln_g + l * RW + c), lb = *(const f32x4*)(p.ln_b + l * RW + c);
  for (int tok = blockIdx.x * 4 + wave; tok < NTOK; tok += gridDim.x * 4) {
    const size_t off = (size_t)tok * RW + c;
    f32x4 y = *(const f32x4*)(p.yy + off) + *(const f32x4*)(p.yy + PL + off);
    float s = y[0] + y[1] + y[2] + y[3];
    s = reduce16(s);
    const float mean = s * (1.f / 64.f);
    f32x4 dlt = y - mean;
    float vs = dlt[0] * dlt[0] + dlt[1] * dlt[1] + dlt[2] * dlt[2] + dlt[3] * dlt[3];
    vs = reduce16(vs);
    const float rs = rsqrtf(vs * (1.f / 64.f) + 64e-5f);
    const float bon = p.bonus[(size_t)tok * 4 + (lane >> 4)];
    const f32x4 vv = *(const f32x4*)(p.sh + (size_t)tok * 768 + (lane >> 4) * 192 + 128 + (lane & 15) * 4), gg = *(const f32x4*)(p.gg + off);
    float o[4];
#pragma unroll
    for (int j = 0; j < 4; ++j) o[j] = (dlt[j] * rs * lg[j] + lb[j] + bon * vv[j]) * gg[j];
    *(half4*)(p.hm + (size_t)tok * DM + 512 + c) = to_half4(o[0], o[1], o[2], o[3]);
  }
}
DI void phase_post(KP p, int l, char* smem) {
  for (int it = blockIdx.x; it < 384; it += gridDim.x) fourierB_tile(p, it, smem);
  phase_rwkv_post(p, l);
}

DI void run_phase(KP p, int ph, char* smem) {
#ifdef ONLY_SP
  const int l = (ph - 1) / 10, sp = ONLY_SP;
  if (ONLY_SP == 10) { phase_prep(p, smem); return; }
  if (ONLY_SP == 11) { phase_final_norm(p); return; }
#else
  if (ph == 0) { phase_prep(p, smem); return; }
  if (ph == NPH - 1) { phase_final_norm(p); return; }
  const int l = (ph - 1) / 10, sp = (ph - 1) % 10;
#endif
  switch (sp) {
    case 0: phase_pre(p); break;
    case 1: phase_inproj(p, l, smem); break;
    case 2: phase_mix_a(p, l, smem); break;
    case 3: phase_mix_b(p, l, smem); break;
    case 4: phase_scan(p, l, smem); break;
    case 5: phase_post(p, l, smem); break;
    case 6: phase_gemm_residual(p, l, p.wt_out + (size_t)l * DM * DM, p.hm, DM, 2, p.hm2, p.ssq + (size_t)(NL + l) * NTOK, p.norm_ffn_g + l * DM, l, 4, smem); break;
    case 7: break;
    case 8: phase_ffn_in(p, l, smem); break;
    case 9: phase_gemm_residual(p, l, p.wt_f2 + (size_t)l * DM * DFF, p.act, DFF, 5, (l + 1 < NL) ? p.hm : (h16*)nullptr, p.ssq + (size_t)(l + 1 < NL ? l + 1 : 0) * NTOK,
                                p.norm_mix_g + (l + 1 < NL ? l + 1 : 0) * DM, (l + 1 < NL ? l + 1 : 0), 1, smem); break;
  }
}
DI bool phase_skipped(int ph) {
  if (ph == 0 || ph == NPH - 1) return false;
  const int l = (ph - 1) / 10, sp = (ph - 1) % 10;
  return sp == 7 || (sp == 0 && l > 0);
}

__global__ void __launch_bounds__(256, 2) hybrid_mega(Params p, int ph_begin, int ph_end) {
  char* smem = g_stage0;
  cg::grid_group grid = cg::this_grid();
  const __attribute__((address_space(4))) Params* kp = (const __attribute__((address_space(4))) Params*)__builtin_amdgcn_kernarg_segment_ptr();
  XcdBarrier xb = xcd_barrier_post(kp->bar);
  for (int ph = ph_begin; ph < ph_end; ++ph) {
    if (phase_skipped(ph)) continue;
    int z; asm volatile("s_mov_b32 %0, 0" : "=s"(z));
    run_phase(kp[z], ph, smem);
#ifdef REPEAT_SP
    if ((ph > 0 && ph < NPH - 1 && (ph - 1) % 10 == REPEAT_SP) || (REPEAT_SP == 10 && ph == 0)) { __syncthreads(); run_phase(kp[z], ph, smem); }
#endif
    if (ph + 1 < ph_end) {
      if (ph_begin < 0) grid.sync();
      xcd_barrier(xb);
    }
  }
}

extern "C" void kernel_launch(void* const* d_in, const int* in_sizes, int n_in, void* d_out, int out_size, void* d_ws, size_t ws_size, hipStream_t stream) {
  static int grid_blocks = 0;
  if (!grid_blocks) {
    int dev = 0, cus = 0, per_cu = 0;
    hipGetDevice(&dev);
    hipDeviceGetAttribute(&cus, hipDeviceAttributeMultiprocessorCount, dev);
    hipOccupancyMaxActiveBlocksPerMultiprocessor(&per_cu, hybrid_mega, 256, 0);
    if (per_cu > 2) per_cu = 2;
    if (per_cu < 1) per_cu = 1;
    grid_blocks = cus * per_cu;
  }
  Params p{};
  const float* const* in = (const float* const*)d_in;
  p.x_prompt = in[0]; p.x_sample = in[1]; p.cache_k = in[2]; p.cache_v = in[3]; p.state_rwkv = in[4]; p.c = in[5]; p.c_ctx = in[6];
  p.w_ada = in[7]; p.b_ada = in[8]; p.norm_mix_g = in[9]; p.norm_ffn_g = in[10]; p.w_in = in[11]; p.w_out = in[12]; p.attn_sink = in[13];
  p.shift_w = in[14]; p.w0 = in[15]; p.w_up = in[16]; p.a0 = in[17]; p.a_up = in[18]; p.g_up = in[19]; p.k_k = in[20]; p.k_a = in[21];
  p.r_k = in[22]; p.ln_g = in[23]; p.ln_b = in[24]; p.ffn_w_in = in[25]; p.ffn_w_out = in[26]; p.norm_final_g = in[27];
  float* out = (float*)d_out;
  p.x = out;
  p.out_k = out + (size_t)NTOK * DM;
  p.out_v = p.out_k + (size_t)16 * NL * 256 * 128;
  p.out_s = p.out_v + (size_t)16 * NL * 256 * 128;
  char* ws = (char*)d_ws; size_t off = 0;
  auto alloc = [&](size_t bytes) { char* r = ws + off; off += (bytes + 255) & ~(size_t)255; return r; };
  p.wt_in = (h16*)alloc((size_t)NL * INW * DM * 2);
  p.wt_out = (h16*)alloc((size_t)NL * DM * DM * 2);
  p.wt_f1 = (h16*)alloc((size_t)NL * 2 * DFF * DM * 2);
  p.wt_f2 = (h16*)alloc((size_t)NL * DM * DFF * 2);
  p.wt_wup = (h16*)alloc((size_t)NL * 2 * RW * 64 * 2);
  p.wt_aup = (h16*)alloc((size_t)NL * 2 * RW * 64 * 2);
  p.wt_gup = (h16*)alloc((size_t)NL * RW * 128 * 2);
  p.cs64t = (h16*)alloc(128 * 128 * 2);
  p.cs_lat = (h16*)alloc((size_t)4096 * 2048 * 2);
  p.cs_ctx = (h16*)alloc(512 * 256 * 2);
  p.ck = (h16*)alloc((size_t)4 * NL * 512 * 128 * 2);
  p.cvt = (h16*)alloc((size_t)4 * NL * 512 * 128 * 2);
  p.mod = (float*)alloc((size_t)NL * 5 * 6144 * 4);
  p.rope = (float*)alloc(2048 * 4);
  p.hm = (h16*)alloc((size_t)NTOK * DM * 2);
  char* qkvz = alloc((size_t)NTOK * 1024 * 2);
  p.qh = (h16*)qkvz; p.kh = p.qh + (size_t)NTOK * 512; p.vt = p.kh + (size_t)NTOK * 128; p.zt = p.vt + (size_t)NTOK * 128;
  p.yy = (float*)alloc((size_t)NTOK * RW * 4 * 2);
  p.pq = (h16*)alloc((size_t)NTOK * 512 * 2);
  char* big = alloc((size_t)NTOK * RW * 4 * 6);
  p.ur = (float*)big; p.dr = (float*)big; p.act = (h16*)big;
  p.sh = (float*)alloc((size_t)NTOK * 768 * 4);
  p.kx = (float*)alloc((size_t)NTOK * RW * 4);
  p.gg = (float*)alloc((size_t)NTOK * RW * 4);
  p.bonus = (float*)alloc((size_t)NTOK * 4 * 4);
  p.tw = (h16*)alloc((size_t)NTOK * 128 * 2);
  p.ad = (h16*)alloc((size_t)NTOK * 128 * 2);
  p.sg = (h16*)alloc((size_t)NTOK * 128 * 2);
  p.bar = (unsigned*)alloc(XCD_BAR_WORDS * 4);
  p.hm2 = (h16*)alloc((size_t)NTOK * DM * 2);
  p.ssq = (float*)alloc((size_t)2 * NL * NTOK * 4);
  p.bias_in = (float*)alloc((size_t)NL * 5 * INW * 4);
  p.bias_f1 = (float*)alloc((size_t)NL * 5 * 2 * DFF * 4);
  if (off > ws_size) { fprintf(stderr, "workspace too small: need %zu have %zu\n", off, ws_size); return; }
  hipMemsetAsync(p.bar, 0, XCD_BAR_WORDS * 4, stream);
#if N_LAUNCH_MODE == 1
  for (int ph = 0; ph < NPH; ++ph) hipLaunchKernelGGL(hybrid_mega, dim3(grid_blocks), dim3(256), 0, stream, p, ph, ph + 1);
#else
  int b0 = 0, b1 = NPH;
  void* args[] = {&p, &b0, &b1};
  hipError_t e = hipLaunchCooperativeKernel((void*)hybrid_mega, dim3(grid_blocks), dim3(256), args, 0, stream);
  if (e != hipSuccess) fprintf(stderr, "cooperative launch failed: %s (grid %d)\n", hipGetErrorString(e), grid_blocks);
#endif
}
```

```cpp
#include <hip/hip_runtime.h>
#include <hip/hip_cooperative_groups.h>
#include <cstdio>
#include <cstdint>
namespace cg = cooperative_groups;

#ifndef N_LAUNCH_MODE
#define N_LAUNCH_MODE 0
#endif

typedef _Float16 h16;
typedef _Float16 half8 __attribute__((ext_vector_type(8)));
typedef _Float16 half4 __attribute__((ext_vector_type(4)));
typedef float f32x16 __attribute__((ext_vector_type(16)));
typedef float f32x4 __attribute__((ext_vector_type(4)));
#define DI __device__ __forceinline__
#define MFMA16(a, b, c) __builtin_amdgcn_mfma_f32_32x32x16_f16((a), (b), (c), 0, 0, 0)

constexpr int DM = 1024, NTOK = 12288, NCTX = 4096, NL = 4, INW = 2176, DFF = 2816, RW = 256;
constexpr int SMEM_BYTES = 73728;
constexpr int NPH = 2 + NL * 10;

struct Params {
  const float *x_prompt, *x_sample, *cache_k, *cache_v, *state_rwkv, *c, *c_ctx, *w_ada, *b_ada, *norm_mix_g, *norm_ffn_g,
      *w_in, *w_out, *attn_sink, *shift_w, *w0, *w_up, *a0, *a_up, *g_up, *k_k, *k_a, *r_k, *ln_g, *ln_b, *ffn_w_in, *ffn_w_out, *norm_final_g;
  float *x, *out_k, *out_v, *out_s;
  h16 *wt_in, *wt_out, *wt_f1, *wt_f2, *wt_wup, *wt_aup, *wt_gup, *cs64t, *cs_lat, *cs_ctx, *ck, *cvt, *hm, *qh, *kh, *vt, *zt, *pq, *tw, *ad, *sg, *act;
  float *mod, *rope, *ur, *dr, *sh, *kx, *bonus, *gg, *yy;
  unsigned* bar;
  h16* hm2; float *ssq, *bias_in, *bias_f1;
};

typedef const __attribute__((address_space(4))) Params& KP;
DI int tidx() { int t = threadIdx.x; asm volatile("" : "+v"(t)); return t; }
template <int CTRL> DI float dpp_mov(float x) { return __int_as_float(__builtin_amdgcn_update_dpp(0, __float_as_int(x), CTRL, 0xF, 0xF, true)); }
DI float reduce8(float x) {
  x += dpp_mov<0xB1>(x);
  x += dpp_mov<0x4E>(x);
  x += dpp_mov<0x141>(x);
  return x;
}
DI float reduce16(float x) { x = reduce8(x); x += dpp_mov<0x140>(x); return x; }
DI float reduce64(float x) {
  x = reduce16(x);
  x += __shfl_xor(x, 16, 64);
  x += __shfl_xor(x, 32, 64);
  return x;
}
DI float sigmoidf_(float x) { return __builtin_amdgcn_rcpf(1.f + __expf(-x)); }
DI void tokinfo(int tok, int& seq0, int& T, int& t, int& ms) {
  if (tok < NCTX) { T = 256; seq0 = tok & ~255; t = tok & 255; ms = 0; }
  else { int u = tok - NCTX; T = 2048; seq0 = NCTX + (u & ~2047); t = u & 2047; ms = 1 + (u >> 11); }
}
DI half4 to_half4(float a, float b, float c, float d) { half4 v; v[0] = (h16)a; v[1] = (h16)b; v[2] = (h16)c; v[3] = (h16)d; return v; }


#define XB_TMO      128
#define XB_XCNT(j)  (256  + 64 * (j))
#define XB_XSUB(j)  (1280 + 64 * (j))
#define XB_XGEN(j)  (2304 + 64 * (j))
#define XB_TOP      3328
#define XB_TOPGEN   3392
#define XCD_BAR_WORDS 3456
#define XB_SPIN_CAP (1u << 22)
#define LAS __attribute__((address_space(3)))
DI unsigned xb_ld(unsigned* p) { return __hip_atomic_load(p, __ATOMIC_RELAXED, __HIP_MEMORY_SCOPE_AGENT); }
DI unsigned xb_add(unsigned* p, unsigned v) { return __hip_atomic_fetch_add(p, v, __ATOMIC_RELAXED, __HIP_MEMORY_SCOPE_AGENT); }
DI unsigned xb_xcc_id() { return (unsigned)__builtin_amdgcn_s_getreg((3 << 11) | 20) & 0xFu; }
#define XB_SPIN(cond, bar) do { unsigned _sp = 0; while (cond) { __builtin_amdgcn_s_sleep(1); \
    if ((++_sp & 255u) == 0u) { if (xb_ld(&(bar)[XB_TMO])) break; if (_sp > XB_SPIN_CAP) { atomicAdd(&(bar)[XB_TMO], 1u); break; } } } } while (0)
struct XcdBarrier { unsigned* bar; unsigned x; unsigned nloc, nx; };
DI XcdBarrier xcd_barrier_post(unsigned* bar) {
  XcdBarrier b; b.bar = bar; b.x = xb_xcc_id(); b.nloc = 0u; b.nx = 0u;
  if (threadIdx.x == 0) (void)xb_add(&bar[XB_XCNT(b.x)], 1u);
  return b;
}
DI void xcd_barrier_complete(unsigned* bar, unsigned x, unsigned& nloc, unsigned& nx) {
  const unsigned G = gridDim.x * gridDim.y * gridDim.z;
  unsigned sum, cnt, mine, sp = 0u;
  for (;;) {
    sum = 0u; cnt = 0u; mine = 0u;
#pragma unroll
    for (unsigned j = 0; j < 16; ++j) { const unsigned c = xb_ld(&bar[XB_XCNT(j)]); sum += c; cnt += (c > 0u) ? 1u : 0u; mine = (j == x) ? c : mine; }
    if (sum == G) break;
    __builtin_amdgcn_s_sleep(1);
    if ((++sp & 255u) == 0u) { if (xb_ld(&bar[XB_TMO])) break; if (sp > XB_SPIN_CAP) { atomicAdd(&bar[XB_TMO], 1u); break; } }
  }
  nloc = mine > 0u ? mine : 1u; nx = cnt > 0u ? cnt : 1u;
}
DI void xcd_barrier(XcdBarrier& b) {
  asm volatile("s_waitcnt vmcnt(0)" ::: "memory");
  __syncthreads();
  if (threadIdx.x == 0) {
    unsigned* bar = b.bar;
    __builtin_amdgcn_s_waitcnt(0);
    unsigned nloc = b.nloc, nx = b.nx;
    if (nloc == 0u) { xcd_barrier_complete(bar, b.x, nloc, nx); b.nloc = nloc; b.nx = nx; }
    const unsigned old = xb_add(&bar[XB_XSUB(b.x)], 1u);
    const unsigned gen = old / nloc;
    if (old + 1u == (gen + 1u) * nloc) {
      __builtin_amdgcn_fence(__ATOMIC_RELEASE, "agent");
      asm volatile("s_waitcnt vmcnt(0)" ::: "memory");
      const unsigned og = xb_add(&bar[XB_TOP], 1u);
      const unsigned tg = og / nx;
      if (og + 1u == (tg + 1u) * nx) xb_add(&bar[XB_TOPGEN], 1u);
      else XB_SPIN(xb_ld(&bar[XB_TOPGEN]) == tg, bar);
      __builtin_amdgcn_fence(__ATOMIC_ACQUIRE, "agent");
      xb_add(&bar[XB_XGEN(b.x)], 1u);
      asm volatile("s_waitcnt vmcnt(0)" ::: "memory");
    } else {
      XB_SPIN(xb_ld(&bar[XB_XGEN(b.x)]) == gen, bar);
      __builtin_amdgcn_fence(__ATOMIC_ACQUIRE, "agent");
      asm volatile("s_waitcnt vmcnt(0)" ::: "memory");
    }
  }
  __syncthreads();
}

__shared__ __attribute__((aligned(1024))) char g_stage0[40960];
__shared__ __attribute__((aligned(1024))) char g_stage1[40960];
template <int NTI>
DI void gemm_mainloop(const h16* W, int ldw, const h16* X, int ldx, int K, char* smem_unused, f32x16 (&acc)[2][NTI], bool pre_issued = false, const h16* Wn = nullptr, const h16* Xn = nullptr) {
  const int tid = tidx(), lane = tid & 63, wave = tid >> 6;
  const int wf = wave >> 1, wt = wave & 1, r = lane & 31, h = lane >> 5;
#pragma unroll
  for (int a = 0; a < 2; ++a)
#pragma unroll
    for (int b = 0; b < NTI; ++b)
#pragma unroll
      for (int i = 0; i < 16; ++i) acc[a][b][i] = 0.f;
  const int lrow = tid >> 3, lc = (tid & 7) ^ ((tid >> 4) & 7);
  const h16* wp = W + (size_t)lrow * ldw + lc * 8;
  const h16* xp = X + (size_t)lrow * ldx + lc * 8;
  const size_t w32 = (size_t)32 * ldw, x32 = (size_t)32 * ldx;
  const int nk = K >> 6;
  const int swz = (r >> 1) & 7;
#define LDSP(p) ((__attribute__((address_space(3))) unsigned*)(p))
#define STAGE(buf, k0) do { \
    _Pragma("unroll") for (int i_ = 0; i_ < 4; ++i_) __builtin_amdgcn_global_load_lds((const unsigned*)(wp + i_ * w32 + (k0)), LDSP(buf + tid * 16 + i_ * 4096), 16, 0, 0); \
    _Pragma("unroll") for (int i_ = 0; i_ < 2 * NTI; ++i_) __builtin_amdgcn_global_load_lds((const unsigned*)(xp + i_ * x32 + (k0)), LDSP(buf + 16384 + tid * 16 + i_ * 4096), 16, 0, 0); } while (0)
#define DSR(dst, addr, off) asm volatile("ds_read_b128 %0, %1 offset:%2" : "=v"(dst) : "v"(addr), "n"(off))
#define COMPUTE(base) do { \
    f32x4 fa_[2], fb_[3], na_[2], nb_[3]; \
    { const unsigned ad_ = (base) + ((0 * 2 + h) ^ swz) * 16; DSR(fa_[0], ad_ + arow, 0); DSR(fa_[1], ad_ + arow, 4096); DSR(fb_[0], ad_ + brow, 16384); DSR(fb_[1], ad_ + brow, 20480); if (NTI == 3) DSR(fb_[2], ad_ + brow, 24576); } \
    _Pragma("unroll") for (int ks = 0; ks < 4; ++ks) { \
      if (ks < 3) { const unsigned ad_ = (base) + (((ks + 1) * 2 + h) ^ swz) * 16; DSR(na_[0], ad_ + arow, 0); DSR(na_[1], ad_ + arow, 4096); DSR(nb_[0], ad_ + brow, 16384); DSR(nb_[1], ad_ + brow, 20480); if (NTI == 3) DSR(nb_[2], ad_ + brow, 24576); \
                    if (NTI == 3) asm volatile("s_waitcnt lgkmcnt(5)" : "+v"(fa_[0]), "+v"(fa_[1]), "+v"(fb_[0]), "+v"(fb_[1]), "+v"(fb_[2])); \
                    else asm volatile("s_waitcnt lgkmcnt(4)" : "+v"(fa_[0]), "+v"(fa_[1]), "+v"(fb_[0]), "+v"(fb_[1])); } \
      else { if (NTI == 3) asm volatile("s_waitcnt lgkmcnt(0)" : "+v"(fa_[0]), "+v"(fa_[1]), "+v"(fb_[0]), "+v"(fb_[1]), "+v"(fb_[2])); \
             else asm volatile("s_waitcnt lgkmcnt(0)" : "+v"(fa_[0]), "+v"(fa_[1]), "+v"(fb_[0]), "+v"(fb_[1])); } \
      _Pragma("unroll") for (int fi_ = 0; fi_ < 2; ++fi_) _Pragma("unroll") for (int ti_ = 0; ti_ < NTI; ++ti_) \
        acc[fi_][ti_] = MFMA16(__builtin_bit_cast(half8, fa_[fi_]), __builtin_bit_cast(half8, fb_[ti_]), acc[fi_][ti_]); \
      fa_[0] = na_[0]; fa_[1] = na_[1]; fb_[0] = nb_[0]; fb_[1] = nb_[1]; if (NTI == 3) fb_[2] = nb_[2]; } } while (0)
  const unsigned s0 = (unsigned)(size_t)g_stage0, s1 = (unsigned)(size_t)g_stage1;
  const unsigned arow = (wf * 64 + r) * 128, brow = (wt * 32 * NTI + r) * 128;
  if (!pre_issued) STAGE(g_stage0, 0);
  asm volatile("s_waitcnt vmcnt(0)" ::: "memory");
  __syncthreads();
  for (int kt = 0; kt < nk; kt += 2) {
    if (kt + 1 < nk) STAGE(g_stage1, (kt + 1) << 6);
    COMPUTE(s0);
    asm volatile("s_waitcnt vmcnt(0)" ::: "memory");
    __syncthreads();
    if (kt + 1 >= nk) break;
    if (kt + 2 < nk) STAGE(g_stage0, (kt + 2) << 6);
    COMPUTE(s1);
    asm volatile("s_waitcnt vmcnt(0)" ::: "memory");
    __syncthreads();
  }
  if (Wn) {
    wp = Wn + (size_t)lrow * ldw + lc * 8;
    xp = Xn + (size_t)lrow * ldx + lc * 8;
    STAGE(g_stage0, 0);
  }
#undef STAGE
#undef COMPUTE
#undef LDSP
#undef DSR
}

template <int NTI>
DI void gemm_issue_next(const h16* Wn, int ldw, const h16* Xn, int ldx) {
  const int tid = tidx();
  const int lrow = tid >> 3, lc = (tid & 7) ^ ((tid >> 4) & 7);
  const h16* wp = Wn + (size_t)lrow * ldw + lc * 8;
  const h16* xp = Xn + (size_t)lrow * ldx + lc * 8;
  const size_t w32 = (size_t)32 * ldw, x32 = (size_t)32 * ldx;
#pragma unroll
  for (int i = 0; i < 4; ++i) __builtin_amdgcn_global_load_lds((const unsigned*)(wp + i * w32), (__attribute__((address_space(3))) unsigned*)(g_stage0 + tid * 16 + i * 4096), 16, 0, 0);
#pragma unroll
  for (int i = 0; i < 2 * NTI; ++i) __builtin_amdgcn_global_load_lds((const unsigned*)(xp + i * x32), (__attribute__((address_space(3))) unsigned*)(g_stage0 + 16384 + tid * 16 + i * 4096), 16, 0, 0);
}

DI int srccol(int n, int mode) {
  if (mode == 0) return n;
  return ((n >> 7) * 64 + ((n >> 6) & 1) * 32 + (n & 31)) + ((n >> 5) & 1) * DFF;
}
struct TDesc { const float* src; h16* dst; int ld, K, n0, k0, mode; };
DI TDesc tdesc(KP p, int it) {
  constexpr int PER_L = 2936;
  const int l = it / PER_L; int idx = it - l * PER_L;
  TDesc d;
  if (idx < 544) { d.src = p.w_in + (size_t)l * DM * INW; d.ld = INW; d.dst = p.wt_in + (size_t)l * INW * DM; d.K = DM; d.n0 = (idx / 16) * 64; d.k0 = (idx % 16) * 64; d.mode = 0; }
  else if (idx < 800) { idx -= 544; d.src = p.w_out + (size_t)l * DM * DM; d.ld = DM; d.dst = p.wt_out + (size_t)l * DM * DM; d.K = DM; d.n0 = (idx / 16) * 64; d.k0 = (idx % 16) * 64; d.mode = 0; }
  else if (idx < 2208) { idx -= 800; d.src = p.ffn_w_in + (size_t)l * DM * 2 * DFF; d.ld = 2 * DFF; d.dst = p.wt_f1 + (size_t)l * 2 * DFF * DM; d.K = DM; d.n0 = (idx / 16) * 64; d.k0 = (idx % 16) * 64; d.mode = 1; }
  else if (idx < 2912) { idx -= 2208; d.src = p.ffn_w_out + (size_t)l * DFF * DM; d.ld = DM; d.dst = p.wt_f2 + (size_t)l * DM * DFF; d.K = DFF; d.n0 = (idx / 44) * 64; d.k0 = (idx % 44) * 64; d.mode = 0; }
  else if (idx < 2920) { idx -= 2912; const int dd = idx / 4; d.src = p.w_up + (size_t)(l * 2 + dd) * 64 * RW; d.ld = RW; d.dst = p.wt_wup + (size_t)(l * 2 + dd) * RW * 64; d.K = 64; d.n0 = (idx % 4) * 64; d.k0 = 0; d.mode = 0; }
  else if (idx < 2928) { idx -= 2920; const int dd = idx / 4; d.src = p.a_up + (size_t)(l * 2 + dd) * 64 * RW; d.ld = RW; d.dst = p.wt_aup + (size_t)(l * 2 + dd) * RW * 64; d.K = 64; d.n0 = (idx % 4) * 64; d.k0 = 0; d.mode = 0; }
  else { idx -= 2928; d.src = p.g_up + (size_t)l * 128 * RW; d.ld = RW; d.dst = p.wt_gup + (size_t)l * RW * 128; d.K = 128; d.n0 = (idx / 2) * 64; d.k0 = (idx % 2) * 64; d.mode = 0; }
  return d;
}
DI void tt_load(const TDesc& d, float (&v)[16]) {
  const int tid = tidx(), j = tid & 63, kq = tid >> 6;
  const float* sp = d.src + (size_t)(d.k0 + kq) * d.ld + srccol(d.n0 + j, d.mode);
#pragma unroll
  for (int i = 0; i < 16; ++i) v[i] = sp[(size_t)(i * 4) * d.ld];
}
DI void tt_store(const TDesc& d, const float (&v)[16], char* smem) {
  float* t = (float*)smem;
  const int tid = tidx(), j = tid & 63, kq = tid >> 6;
#pragma unroll
  for (int i = 0; i < 16; ++i) t[j * 65 + i * 4 + kq] = v[i];
  __syncthreads();
  const int row = tid >> 2, seg = tid & 3;
  half8 v0, v1;
#pragma unroll
  for (int i = 0; i < 8; ++i) { v0[i] = (h16)t[row * 65 + seg * 16 + i]; v1[i] = (h16)t[row * 65 + seg * 16 + 8 + i]; }
  h16* dp = d.dst + (size_t)(d.n0 + row) * d.K + d.k0 + seg * 16;
  *(half8*)dp = v0; *(half8*)(dp + 8) = v1;
  __syncthreads();
}

DI void phase_prep(KP p, char* smem) {
  const int tid = tidx(), G = gridDim.x;
  {
    constexpr int TOTAL = NL * 2936;
    int it = blockIdx.x;
    if (it < TOTAL) {
      TDesc d = tdesc(p, it);
      float v[16];
      tt_load(d, v);
      for (;;) {
        const int nit = it + G;
        const bool has = nit < TOTAL;
        TDesc nd = d; float nv[16];
#pragma unroll
        for (int i = 0; i < 16; ++i) nv[i] = 0.f;
        if (has) { nd = tdesc(p, nit); tt_load(nd, nv); }
        asm volatile("" ::: "memory");
        tt_store(d, v, smem);
        if (!has) break;
        d = nd; it = nit;
#pragma unroll
        for (int i = 0; i < 16; ++i) v[i] = nv[i];
      }
    }
  }
  {
    float* sv = (float*)smem;
    float* red = sv + 5 * 1024;
    for (int it = blockIdx.x; it < NL * 96; it += G) {
      const int l = it / 96, cgp = it % 96;
      for (int i = tid; i < 5 * 1024; i += 256) {
        const int s = i >> 10, k = i & 1023;
        const float v = (s == 0) ? p.c_ctx[k] : p.c[(s - 1) * 1024 + k];
        sv[i] = v * sigmoidf_(v);
      }
      __syncthreads();
      const int col = cgp * 64 + (tid & 63), kq = tid >> 6;
      float a0 = 0, a1 = 0, a2 = 0, a3 = 0, a4 = 0;
      const float* w = p.w_ada + (size_t)l * DM * 6144 + col;
#pragma unroll 32
      for (int k = kq * 256; k < kq * 256 + 256; ++k) {
        const float wv = w[(size_t)k * 6144];
        a0 += sv[k] * wv; a1 += sv[1024 + k] * wv; a2 += sv[2048 + k] * wv; a3 += sv[3072 + k] * wv; a4 += sv[4096 + k] * wv;
      }
      float* rp = red + kq * 320 + (tid & 63);
      rp[0] = a0; rp[64] = a1; rp[128] = a2; rp[192] = a3; rp[256] = a4;
      __syncthreads();
      for (int i = tid; i < 320; i += 256) {
        const int s = i >> 6, cc = i & 63;
        const float v = red[i] + red[320 + i] + red[640 + i] + red[960 + i] + p.b_ada[l * 6144 + cgp * 64 + cc];
        p.mod[((size_t)l * 5 + s) * 6144 + cgp * 64 + cc] = v;
      }
      __syncthreads();
    }
  }
  const int gtid = blockIdx.x * 256 + tid, gstride = G * 256;
  for (int i = gtid; i < 4096 * 2048; i += gstride) {
    const int m = i >> 11, t = i & 2047;
    const int idx = ((m & 2047) * t) & 2047;
    const float ang = (float)idx * (1.f / 1024.f);
    p.cs_lat[i] = (h16)((m < 2048) ? cospif(ang) : sinpif(ang));
  }
  for (int i = gtid; i < 512 * 256; i += gstride) {
    const int m = i >> 8, t = i & 255;
    const int idx = ((m & 255) * t) & 255;
    const float ang = (float)idx * (1.f / 128.f);
    p.cs_ctx[i] = (h16)((m < 256) ? cospif(ang) : sinpif(ang));
  }
  for (int i = gtid; i < 128 * 128; i += gstride) {
    const int cp = i >> 7, k = i & 127;
    float v = 0.f;
    if (cp < 64) { const int idx = ((k & 63) * cp) & 63; const float ang = (float)idx * (1.f / 32.f); v = (k < 64) ? cospif(ang) : -sinpif(ang); }
    p.cs64t[i] = (h16)v;
  }
  for (int i = gtid; i < 1024; i += gstride) {
    const int pos = i >> 4, q = i & 15;
    const float inv = powf(10000.f, -(float)q / 16.f);
    const float ang = (float)pos * inv;
    p.rope[i] = cosf(ang); p.rope[1024 + i] = sinf(ang);
  }
  for (int i0 = gtid; i0 < 4 * NL * 512 * 128; i0 += 4 * gstride) {
    float kv[4], vv[4];
#pragma unroll
    for (int u = 0; u < 4; ++u) { const int i = i0 + u * gstride; const bool ok = i < 4 * NL * 512 * 128; kv[u] = ok ? p.cache_k[i] : 0.f; vv[u] = ok ? p.cache_v[i] : 0.f; }
#pragma unroll
    for (int u = 0; u < 4; ++u) {
      const int i = i0 + u * gstride;
      if (i < 4 * NL * 512 * 128) {
        const int d = i & 63, kvh = (i >> 6) & 1, pos = (i >> 7) & 511, bl = i >> 16;
        p.ck[(((size_t)bl * 2 + kvh) * 512 + pos) * 64 + d] = (h16)kv[u];
        p.cvt[(((size_t)bl * 2 + kvh) * 64 + d) * 512 + pos] = (h16)vv[u];
      }
    }
  }
  for (int i = gtid; i < 2 * NL * NTOK; i += gstride) p.ssq[i] = 0.f;
  {
    constexpr int NV = NTOK * DM / 4, NP = NCTX * DM / 4;
    for (int i0 = gtid; i0 < NV; i0 += 8 * gstride) {
      f32x4 v[8];
#pragma unroll
      for (int u = 0; u < 8; ++u) { const int i = i0 + u * gstride; v[u] = (i < NV) ? ((i < NP) ? ((const f32x4*)p.x_prompt)[i] : ((const f32x4*)p.x_sample)[i - NP]) : (f32x4){0.f, 0.f, 0.f, 0.f}; }
#pragma unroll
      for (int u = 0; u < 8; ++u) { const int i = i0 + u * gstride; if (i < NV) ((f32x4*)p.x)[i] = v[u]; }
    }
  }
}

DI void phase_pre(KP p) {
  const int lane = tidx() & 63, wave = tidx() >> 6;
  const int gw = blockIdx.x * 4 + wave, nw = gridDim.x * 4;
  for (int tok = gw; tok < NTOK; tok += nw) {
    int seq0, T, t, ms; tokinfo(tok, seq0, T, t, ms);
    const float* mod = p.mod + (size_t)ms * 6144;
    const float* xr = p.x + (size_t)tok * DM;
    float ss = 0.f;
#pragma unroll
    for (int i = 0; i < 4; ++i) {
      const int c = i * 256 + lane * 4;
      const f32x4 v = *(const f32x4*)(xr + c), gv = *(const f32x4*)(p.norm_mix_g + c), sc = *(const f32x4*)(mod + 1024 + c);
      ss += v[0] * v[0] + v[1] * v[1] + v[2] * v[2] + v[3] * v[3];
      *(half4*)(p.hm + (size_t)tok * DM + c) = to_half4(v[0] * gv[0] * (1.f + sc[0]), v[1] * gv[1] * (1.f + sc[1]), v[2] * gv[2] * (1.f + sc[2]), v[3] * gv[3] * (1.f + sc[3]));
    }
    ss = reduce64(ss);
    if (lane == 0) p.ssq[tok] = ss;
  }
  constexpr int RPL = INW + 2 * DFF;
  for (int row = gw; row < NL * RPL; row += nw) {
    const int l = row / RPL, rr = row - l * RPL;
    const bool ffn = rr >= INW;
    const int n = ffn ? rr - INW : rr;
    const h16* wrow = (ffn ? p.wt_f1 + (size_t)l * 2 * DFF * DM : p.wt_in + (size_t)l * INW * DM) + (size_t)n * DM + lane * 16;
    const half8 w0 = *(const half8*)wrow, w1 = *(const half8*)(wrow + 8);
    float wv[16];
#pragma unroll
    for (int j = 0; j < 8; ++j) { wv[j] = (float)w0[j]; wv[8 + j] = (float)w1[j]; }
    float* dst = (ffn ? p.bias_f1 + (size_t)l * 5 * 2 * DFF : p.bias_in + (size_t)l * 5 * INW) + n;
#pragma unroll
    for (int sidx = 0; sidx < 5; ++sidx) {
      const float* sh = p.mod + ((size_t)l * 5 + sidx) * 6144 + (ffn ? 3 * 1024 : 0) + lane * 16;
      float d = 0.f;
#pragma unroll
      for (int q = 0; q < 4; ++q) { const f32x4 sv = *(const f32x4*)(sh + 4 * q); d += sv[0] * wv[4 * q] + sv[1] * wv[4 * q + 1] + sv[2] * wv[4 * q + 2] + sv[3] * wv[4 * q + 3]; }
      d = reduce64(d);
      if (lane == 0) dst[(size_t)sidx * (ffn ? 2 * DFF : INW)] = d;
    }
  }
}
DI void phase_final_norm(KP p) {
  const int lane = tidx() & 63, wave = tidx() >> 6;
  for (int tok = blockIdx.x * 4 + wave; tok < NTOK; tok += gridDim.x * 4) {
    float* xr = p.x + (size_t)tok * DM;
    f32x4 v[4]; float ss = 0.f;
#pragma unroll
    for (int i = 0; i < 4; ++i) { v[i] = *(const f32x4*)(xr + i * 256 + lane * 4); ss += v[i][0] * v[i][0] + v[i][1] * v[i][1] + v[i][2] * v[i][2] + v[i][3] * v[i][3]; }
    ss = reduce64(ss);
    const float rstd = rsqrtf(ss * (1.f / 1024.f) + 1e-6f);
#pragma unroll
    for (int i = 0; i < 4; ++i) {
      const int c = i * 256 + lane * 4;
      const f32x4 gv = *(const f32x4*)(p.norm_final_g + c);
      f32x4 o;
#pragma unroll
      for (int j = 0; j < 4; ++j) o[j] = v[i][j] * rstd * gv[j];
      *(f32x4*)(xr + c) = o;
    }
  }
}

DI bool xcd_tile(int k, int nft, int& tt, int& ft, int tpx = 12) {
  const int x = blockIdx.x & 7, j = blockIdx.x >> 3, J = gridDim.x >> 3;
  const int i = j + J * k;
  if (i >= tpx * nft) return false;
  tt = tpx * x + i % tpx; ft = i / tpx;
  return true;
}
DI void phase_inproj(KP p, int l, char* smem) {
  const int lane = tidx() & 63, wave = tidx() >> 6, wf = wave >> 1, wt = wave & 1, r = lane & 31, h = lane >> 5;
  const h16* W = p.wt_in + (size_t)l * INW * DM;
  int tt, ft, tt2 = 0, ft2 = 0;
  bool have = xcd_tile(0, 17, tt, ft), pre = false;
  for (int k = 0; have; ++k, tt = tt2, ft = ft2) {
    const bool have2 = xcd_tile(k + 1, 17, tt2, ft2);
    f32x16 acc[2][2];
    gemm_mainloop<2>(W + (size_t)ft * 128 * DM, DM, p.hm + (size_t)tt * 128 * DM, DM, DM, smem, acc, pre);
    pre = have2; have = have2;
    int msv[2]; float rq[2];
#pragma unroll
    for (int ti = 0; ti < 2; ++ti) {
      const int tok_ = tt * 128 + wt * 64 + ti * 32 + r;
      int sq_, T_, t_; tokinfo(tok_, sq_, T_, t_, msv[ti]);
      rq[ti] = p.ssq[(size_t)l * NTOK + tok_];
    }
    const bool uni = __all((msv[0] == msv[1]) && (msv[0] == __builtin_amdgcn_readfirstlane(msv[0])));
    f32x4 bi[2][4];
#pragma unroll
    for (int fi = 0; fi < 2; ++fi)
#pragma unroll
      for (int g = 0; g < 4; ++g) bi[fi][g] = *(const f32x4*)(p.bias_in + ((size_t)l * 5 + msv[0]) * INW + ft * 128 + wf * 64 + fi * 32 + 4 * h + 8 * g);
    asm volatile("" ::: "memory");
    if (have2) gemm_issue_next<2>(W + (size_t)ft2 * 128 * DM, DM, p.hm + (size_t)tt2 * 128 * DM, DM);
#pragma unroll
    for (int fi = 0; fi < 2; ++fi)
#pragma unroll
      for (int ti = 0; ti < 2; ++ti) {
        const int nb = ft * 128 + wf * 64 + fi * 32;
        const int tok = tt * 128 + wt * 64 + ti * 32 + r;
        int seq0, T, t, ms; tokinfo(tok, seq0, T, t, ms);
        const bool lat = tok >= NCTX;
        f32x16 a = acc[fi][ti];
        {
          const float rstd = rsqrtf(rq[ti] * (1.f / 1024.f) + 1e-6f);
          const float* bp = p.bias_in + ((size_t)l * 5 + ms) * INW + nb + 4 * h;
#pragma unroll
          for (int g = 0; g < 4; ++g) { const f32x4 bv = uni ? bi[fi][g] : *(const f32x4*)(bp + 8 * g);
#pragma unroll
            for (int j = 0; j < 4; ++j) a[4 * g + j] = a[4 * g + j] * rstd + bv[j]; }
        }
        if (nb < 640) {
          if (lat) {
            const int pos = (nb & 32) ? (t & 63) : (t >> 6);
#pragma unroll
            for (int i = 0; i < 8; ++i) {
              const int q = (i & 3) + 8 * (i >> 2) + 4 * h;
              const float cs = p.rope[pos * 16 + q], sn = p.rope[1024 + pos * 16 + q];
              const float x1 = a[i], x2 = a[i + 8];
              a[i] = x1 * cs - x2 * sn; a[i + 8] = x2 * cs + x1 * sn;
            }
          }
          if (nb < 512) {
#pragma unroll
            for (int g = 0; g < 4; ++g)
              *(half4*)(p.qh + (size_t)tok * 512 + nb + 4 * h + 8 * g) = to_half4(a[4 * g] * 0.125f, a[4 * g + 1] * 0.125f, a[4 * g + 2] * 0.125f, a[4 * g + 3] * 0.125f);
          } else {
            const int kvh = (nb - 512) >> 6;
#pragma unroll
            for (int g = 0; g < 4; ++g) {
              *(half4*)(p.kh + ((size_t)kvh * NTOK + tok) * 64 + (nb & 63) + 4 * h + 8 * g) = to_half4(a[4 * g], a[4 * g + 1], a[4 * g + 2], a[4 * g + 3]);
              if (!lat) {
                f32x4 o = {a[4 * g], a[4 * g + 1], a[4 * g + 2], a[4 * g + 3]};
                *(f32x4*)(p.out_k + (((size_t)(tok >> 8) * NL + l) * 256 + t) * 128 + (nb - 512) + 4 * h + 8 * g) = o;
              }
            }
          }
        } else if (nb < 768) {
          const int c0 = nb - 640;
#pragma unroll
          for (int g = 0; g < 4; ++g) {
#pragma unroll
            for (int j = 0; j < 4; ++j) p.vt[(size_t)seq0 * 128 + (size_t)(c0 + 4 * h + 8 * g + j) * T + t] = (h16)a[4 * g + j];
            if (!lat) {
              f32x4 o = {a[4 * g], a[4 * g + 1], a[4 * g + 2], a[4 * g + 3]};
              *(f32x4*)(p.out_v + (((size_t)(tok >> 8) * NL + l) * 256 + t) * 128 + c0 + 4 * h + 8 * g) = o;
            }
          }
        } else if (nb < 1920) {
#pragma unroll
          for (int g = 0; g < 4; ++g) {
            f32x4 o = {a[4 * g], a[4 * g + 1], a[4 * g + 2], a[4 * g + 3]};
            *(f32x4*)(p.ur + (size_t)tok * 1152 + (nb - 768) + 4 * h + 8 * g) = o;
          }
        } else {
          const int c0 = nb - 1920;
#pragma unroll
          for (int g = 0; g < 4; ++g)
#pragma unroll
            for (int j = 0; j < 4; ++j) p.zt[(size_t)seq0 * 256 + (size_t)(c0 + 4 * h + 8 * g + j) * T + t] = (h16)a[4 * g + j];
        }
      }
  }
}

DI void phase_gemm_residual(KP p, int l, const h16* W, const h16* X, int K, int gate_idx, h16* xg_out, float* ssq_out, const float* ng, int nl, int sc_idx, char* smem) {
  const int lane = tidx() & 63, wave = tidx() >> 6, wf = wave >> 1, wt = wave & 1, r = lane & 31, h = lane >> 5;
  int tt, ft, tt2 = 0, ft2 = 0;
  bool have = xcd_tile(0, 8, tt, ft, 8), pre = false;
  for (int k = 0; have; ++k, tt = tt2, ft = ft2) {
    const bool have2 = xcd_tile(k + 1, 8, tt2, ft2, 8);
    f32x16 acc[2][3];
    gemm_mainloop<3>(W + (size_t)ft * 128 * K, K, X + (size_t)tt * 192 * K, K, K, smem, acc, pre,
                     have2 ? W + (size_t)ft2 * 128 * K : (const h16*)nullptr, have2 ? X + (size_t)tt2 * 192 * K : (const h16*)nullptr);
    pre = have2; have = have2;
#pragma unroll
    for (int ti = 0; ti < 3; ++ti) {
      const int tok = tt * 192 + wt * 96 + ti * 32 + r;
      int seq0, T, t, ms; tokinfo(tok, seq0, T, t, ms);
      const float* gate = p.mod + ((size_t)l * 5 + ms) * 6144 + gate_idx * 1024;
      const float* nsc = p.mod + ((size_t)nl * 5 + ms) * 6144 + sc_idx * 1024;
      float ss = 0.f;
#pragma unroll
      for (int fi = 0; fi < 2; ++fi) {
        const int nb = ft * 128 + wf * 64 + fi * 32 + 4 * h;
#pragma unroll
        for (int g = 0; g < 4; ++g) {
          const int n = nb + 8 * g;
          const f32x4 gv = *(const f32x4*)(gate + n);
          f32x4* xp = (f32x4*)(p.x + (size_t)tok * DM + n);
          f32x4 xv = *xp;
#pragma unroll
          for (int j = 0; j < 4; ++j) xv[j] += gv[j] * acc[fi][ti][4 * g + j];
          *xp = xv;
          if (xg_out) {
            const f32x4 g2 = *(const f32x4*)(ng + n), s2 = *(const f32x4*)(nsc + n);
            ss += xv[0] * xv[0] + xv[1] * xv[1] + xv[2] * xv[2] + xv[3] * xv[3];
            *(half4*)(xg_out + (size_t)tok * DM + n) = to_half4(xv[0] * g2[0] * (1.f + s2[0]), xv[1] * g2[1] * (1.f + s2[1]), xv[2] * g2[2] * (1.f + s2[2]), xv[3] * g2[3] * (1.f + s2[3]));
          }
        }
      }
      if (xg_out) {
        ss += __shfl_xor(ss, 32, 64);
        if (h == 0) __hip_atomic_fetch_add(ssq_out + tok, ss, __ATOMIC_RELAXED, __HIP_MEMORY_SCOPE_AGENT);
      }
    }
  }
}

DI void phase_ffn_in(KP p, int l, char* smem) {
  const int lane = tidx() & 63, wave = tidx() >> 6, wf = wave >> 1, wt = wave & 1, r = lane & 31, h = lane >> 5;
  const h16* W = p.wt_f1 + (size_t)l * 2 * DFF * DM;
  int tt, ft, tt2 = 0, ft2 = 0;
  bool have = xcd_tile(0, 44, tt, ft, 8), pre = false;
  for (int k = 0; have; ++k, tt = tt2, ft = ft2) {
    const bool have2 = xcd_tile(k + 1, 44, tt2, ft2, 8);
    f32x16 acc[2][3];
    gemm_mainloop<3>(W + (size_t)ft * 128 * DM, DM, p.hm2 + (size_t)tt * 192 * DM, DM, DM, smem, acc, pre);
    pre = have2; have = have2;
    int msv[3]; float rstd[3];
#pragma unroll
    for (int ti = 0; ti < 3; ++ti) {
      const int tok = tt * 192 + wt * 96 + ti * 32 + r;
      int seq0, T, t; tokinfo(tok, seq0, T, t, msv[ti]);
      rstd[ti] = p.ssq[(size_t)(NL + l) * NTOK + tok];
    }
    const bool uni = __all((msv[0] == msv[1]) && (msv[1] == msv[2]) && (msv[0] == __builtin_amdgcn_readfirstlane(msv[0])));
    const float* bp0 = p.bias_f1 + ((size_t)l * 5 + msv[0]) * 2 * DFF + ft * 128 + wf * 64 + 4 * h;
    f32x4 bg[4], bu[4];
#pragma unroll
    for (int g = 0; g < 4; ++g) { bg[g] = *(const f32x4*)(bp0 + 8 * g); bu[g] = *(const f32x4*)(bp0 + 32 + 8 * g); }
    asm volatile("" ::: "memory");
    if (have2) gemm_issue_next<3>(W + (size_t)ft2 * 128 * DM, DM, p.hm2 + (size_t)tt2 * 192 * DM, DM);
    char* tw_ = g_stage1 + wave * 7680;
#pragma unroll
    for (int ti = 0; ti < 3; ++ti) {
      const float rs = rsqrtf(rstd[ti] * (1.f / 1024.f) + 1e-6f);
      if (!uni) {
        const float* bp = p.bias_f1 + ((size_t)l * 5 + msv[ti]) * 2 * DFF + ft * 128 + wf * 64 + 4 * h;
#pragma unroll
        for (int g = 0; g < 4; ++g) { bg[g] = *(const f32x4*)(bp + 8 * g); bu[g] = *(const f32x4*)(bp + 32 + 8 * g); }
      }
#pragma unroll
      for (int g = 0; g < 4; ++g) {
        float o[4];
#pragma unroll
        for (int j = 0; j < 4; ++j) { const float gt = acc[0][ti][4 * g + j] * rs + bg[g][j], up = acc[1][ti][4 * g + j] * rs + bu[g][j]; o[j] = gt * sigmoidf_(gt) * up; }
        *(half4*)(tw_ + ti * 2560 + r * 80 + (4 * h + 8 * g) * 2) = to_half4(o[0], o[1], o[2], o[3]);
      }
    }
    asm volatile("" ::: "memory");
    __builtin_amdgcn_wave_barrier();
#pragma unroll
    for (int ti = 0; ti < 3; ++ti)
#pragma unroll
      for (int q = 0; q < 2; ++q) {
        const int tl = q * 16 + (lane >> 2), ch = lane & 3;
        const uint4 v = *(const uint4*)(tw_ + ti * 2560 + tl * 80 + ch * 16);
        *(uint4*)(p.act + (size_t)(tt * 192 + wt * 96 + ti * 32 + tl) * DFF + ft * 64 + wf * 32 + ch * 8) = v;
      }
    asm volatile("" ::: "memory");
    __builtin_amdgcn_wave_barrier();
  }
}

DI void attn_tiles(const h16* Kb, const h16* Vtb, int ldv, int kt_begin, int kt_end, bool masked, int q0, const half8 (&qf)[4],
                   float& m, float& lsum, f32x16& o0, f32x16& o1, int r, int h) {
  half8 kc0, kc1, kc2, kc3;
  {
    const h16* kp = Kb + (size_t)(kt_begin * 32 + r) * 64 + h * 8;
    kc0 = *(const half8*)kp; kc1 = *(const half8*)(kp + 16); kc2 = *(const half8*)(kp + 32); kc3 = *(const half8*)(kp + 48);
  }
  for (int kt = kt_begin; kt < kt_end; ++kt) {
    const int key0 = kt * 32;
    const h16* vp0 = Vtb + (size_t)r * ldv + key0 + 4 * h;
    const h16* vp1 = vp0 + (size_t)32 * ldv;
    const half4 v00l = *(const half4*)vp0, v00h = *(const half4*)(vp0 + 8), v01l = *(const half4*)(vp0 + 16), v01h = *(const half4*)(vp0 + 24);
    const half4 v10l = *(const half4*)vp1, v10h = *(const half4*)(vp1 + 8), v11l = *(const half4*)(vp1 + 16), v11h = *(const half4*)(vp1 + 24);
    half8 kn0 = kc0, kn1 = kc1, kn2 = kc2, kn3 = kc3;
    if (kt + 1 < kt_end) {
      const h16* kp = Kb + (size_t)(key0 + 32 + r) * 64 + h * 8;
      kn0 = *(const half8*)kp; kn1 = *(const half8*)(kp + 16); kn2 = *(const half8*)(kp + 32); kn3 = *(const half8*)(kp + 48);
    }
    asm volatile("" ::: "memory");
    f32x16 x;
#pragma unroll
    for (int i = 0; i < 16; ++i) x[i] = 0.f;
    x = MFMA16(kc0, qf[0], x); x = MFMA16(kc1, qf[1], x); x = MFMA16(kc2, qf[2], x); x = MFMA16(kc3, qf[3], x);
    if (masked) {
      const int qpos = q0 + r;
#pragma unroll
      for (int i = 0; i < 16; ++i) {
        const int key = key0 + (i & 3) + 8 * (i >> 2) + 4 * h;
        const int d = key - qpos;
        if (d > 128 || d < -128) x[i] = -1e30f;
      }
    }
    float tmax = x[0];
#pragma unroll
    for (int i = 1; i < 16; ++i) tmax = fmaxf(tmax, x[i]);
    tmax = fmaxf(tmax, __shfl_xor(tmax, 32, 64));
    const float mnew = fmaxf(m, tmax);
    const float alpha = __expf(m - mnew);
    m = mnew;
    float ps = 0.f;
#pragma unroll
    for (int i = 0; i < 16; ++i) { x[i] = __expf(x[i] - mnew); ps += x[i]; }
    lsum = lsum * alpha + ps;
#pragma unroll
    for (int i = 0; i < 16; ++i) { o0[i] *= alpha; o1[i] *= alpha; }
    half8 pf0, pf1;
#pragma unroll
    for (int j = 0; j < 8; ++j) { pf0[j] = (h16)x[j]; pf1[j] = (h16)x[8 + j]; }
    o0 = MFMA16(__builtin_shufflevector(v00l, v00h, 0, 1, 2, 3, 4, 5, 6, 7), pf0, o0);
    o1 = MFMA16(__builtin_shufflevector(v10l, v10h, 0, 1, 2, 3, 4, 5, 6, 7), pf0, o1);
    o0 = MFMA16(__builtin_shufflevector(v01l, v01h, 0, 1, 2, 3, 4, 5, 6, 7), pf1, o0);
    o1 = MFMA16(__builtin_shufflevector(v11l, v11h, 0, 1, 2, 3, 4, 5, 6, 7), pf1, o1);
    kc0 = kn0; kc1 = kn1; kc2 = kn2; kc3 = kn3;
  }
}
DI void attn_item(KP p, int l, int bitem) {
  const int lane = tidx() & 63, wave = tidx() >> 6, r = lane & 31, h = lane >> 5;
  const bool lat = bitem < 512;
  int b, qt, kvh;
  if (lat) { kvh = bitem & 1; qt = (bitem >> 1) & 63; b = bitem >> 7; }
  else { const int c = bitem - 512; kvh = c & 1; qt = (c >> 1) & 7; b = c >> 4; }
  const int head = kvh * 4 + wave;
  const int T = lat ? 2048 : 256, tok0 = lat ? NCTX + b * 2048 : b * 256, q0 = qt * 32;
  half8 qf[4];
#pragma unroll
  for (int s = 0; s < 4; ++s) qf[s] = *(const half8*)(p.qh + (size_t)(tok0 + q0 + r) * 512 + head * 64 + s * 16 + h * 8);
  float m = p.attn_sink[l * 8 + head], lsum = (h == 0) ? 1.f : 0.f;
  f32x16 o0, o1;
#pragma unroll
  for (int i = 0; i < 16; ++i) { o0[i] = 0.f; o1[i] = 0.f; }
  const h16* Kb = p.kh + ((size_t)kvh * NTOK + tok0) * 64;
  const h16* Vtb = p.vt + (size_t)tok0 * 128 + (size_t)kvh * 64 * T;
  if (lat) {
    int kb = (q0 - 128) >> 5; if (kb < 0) kb = 0;
    int ke = ((q0 + 159) >> 5) + 1; if (ke > 64) ke = 64;
    attn_tiles(Kb, Vtb, T, kb, ke, true, q0, qf, m, lsum, o0, o1, r, h);
    const size_t cb = ((size_t)(b * NL + l) * 2 + kvh);
    attn_tiles(p.ck + cb * 512 * 64, p.cvt + cb * 64 * 512, 512, 0, 16, false, q0, qf, m, lsum, o0, o1, r, h);
  } else {
    attn_tiles(Kb, Vtb, T, 0, 8, false, q0, qf, m, lsum, o0, o1, r, h);
  }
  const float ltot = lsum + __shfl_xor(lsum, 32, 64);
  const float inv = 1.f / ltot;
  h16* op = p.hm + (size_t)(tok0 + q0 + r) * DM + head * 64 + 4 * h;
#pragma unroll
  for (int g = 0; g < 4; ++g) {
    *(half4*)(op + 8 * g) = to_half4(o0[4 * g] * inv, o0[4 * g + 1] * inv, o0[4 * g + 2] * inv, o0[4 * g + 3] * inv);
    *(half4*)(op + 32 + 8 * g) = to_half4(o1[4 * g] * inv, o1[4 * g + 1] * inv, o1[4 * g + 2] * inv, o1[4 * g + 3] * inv);
  }
}

template <bool LAT> DI void fourierA_item(KP p, int item, char* smem) {
  const int lane = tidx() & 63, wave = tidx() >> 6, wf = wave >> 1, wt = wave & 1, r = lane & 31, h = lane >> 5;
  constexpr int T = LAT ? 2048 : 256;
  int tok0, mt, ft; const h16* tab;
  if (LAT) { const int seq = item >> 6; mt = (item >> 1) & 31; ft = item & 1; tok0 = NCTX + seq * 2048; tab = p.cs_lat; }
  else { const int c = item - 256; const int seq = c >> 3; mt = (c >> 1) & 3; ft = c & 1; tok0 = seq * 256; tab = p.cs_ctx; }
  f32x16 acc[2][2];
  gemm_mainloop<2>(p.zt + (size_t)tok0 * 256 + (size_t)ft * 128 * T, T, tab + (size_t)mt * 128 * T, T, T, smem, acc);
#pragma unroll
  for (int fi = 0; fi < 2; ++fi)
#pragma unroll
    for (int ti = 0; ti < 2; ++ti) {
      const int n = ft * 128 + wf * 64 + fi * 32 + 4 * h;
      const int mm = mt * 128 + wt * 64 + ti * 32 + r;
      const int tp = mm & (T - 1), sc = (mm >= T) ? 1 : 0;
      h16* dst = p.pq + (size_t)(tok0 + tp) * 512 + (n >> 6) * 128 + sc * 64 + (n & 63);
#pragma unroll
      for (int g = 0; g < 4; ++g) *(half4*)(dst + 8 * g) = to_half4(acc[fi][ti][4 * g], acc[fi][ti][4 * g + 1], acc[fi][ti][4 * g + 2], acc[fi][ti][4 * g + 3]);
    }
}

DI void rwkv_prep_token(KP p, int l, int tok, int lane_) {
  const int lane = tidx() & 63;
  int seq0, T, t, ms; tokinfo(tok, seq0, T, t, ms);
  const bool hp = t > 0, hn = t < T - 1;
  const float* u = p.ur + (size_t)tok * 1152;
  const float* sw = p.shift_w + (size_t)l * 3 * 1152;
  f32x4 sec[5];
#pragma unroll
  for (int i = 0; i < 5; ++i) {
    const int c = i * 256 + lane * 4;
    f32x4 o = {0.f, 0.f, 0.f, 0.f};
    if (i < 4 || lane < 32) {
      const f32x4 w1 = *(const f32x4*)(sw + 1152 + c);
      o = *(const f32x4*)(u + c) * w1;
      if (hp) o += *(const f32x4*)(u - 1152 + c) * *(const f32x4*)(sw + c);
      if (hn) o += *(const f32x4*)(u + 1152 + c) * *(const f32x4*)(sw + 2304 + c);
    }
    sec[i] = o;
  }
  const int c = lane * 4;
  const f32x4 r4 = sec[0], k4 = sec[1], v4 = sec[2];
  float* shp = p.sh + (size_t)tok * 768 + (lane >> 4) * 192 + (lane & 15) * 4;
  *(f32x4*)(shp + 64) = r4;
  *(f32x4*)(p.kx + (size_t)tok * RW + c) = k4;
  *(f32x4*)(shp + 128) = v4;
  const f32x4 kkw = *(const f32x4*)(p.k_k + l * RW + c);
  f32x4 kk = k4 * kkw;
  float ss = kk[0] * kk[0] + kk[1] * kk[1] + kk[2] * kk[2] + kk[3] * kk[3];
  ss = reduce16(ss);
  const float rn = rsqrtf(ss + 1e-12f);
  kk = kk * rn;
  *(f32x4*)shp = kk;
  const f32x4 rk = *(const f32x4*)(p.r_k + l * RW + c);
  float bs = r4[0] * k4[0] * rk[0] + r4[1] * k4[1] * rk[1] + r4[2] * k4[2] * rk[2] + r4[3] * k4[3] * rk[3];
  bs = reduce16(bs);
  if ((lane & 15) == 0) p.bonus[(size_t)tok * 4 + (lane >> 4)] = bs;
  if (lane < 32) {
    const f32x4 gd = sec[3];
    *(half4*)(p.sg + (size_t)tok * 128 + lane * 4) = to_half4(sigmoidf_(gd[0]), sigmoidf_(gd[1]), sigmoidf_(gd[2]), sigmoidf_(gd[3]));
    const f32x4 ad = sec[4];
    *(half4*)(p.ad + (size_t)tok * 128 + lane * 4) = to_half4(ad[0], ad[1], ad[2], ad[3]);
  } else {
    const f32x4 wd = sec[3];
    *(half4*)(p.tw + (size_t)tok * 128 + (lane - 32) * 4) = to_half4(tanhf(wd[0]), tanhf(wd[1]), tanhf(wd[2]), tanhf(wd[3]));
  }
}

DI int first_item(int off) { const int G = gridDim.x; return (int)((blockIdx.x + G - (off % G)) % G); }
DI void phase_mix_a(KP p, int l, char* smem) {
  const int lane = tidx() & 63, wave = tidx() >> 6, G = gridDim.x;
  for (int it = blockIdx.x; it < 768; it += G) {
    const int base = it * 16;
    for (int j = 0; j < 4; ++j) rwkv_prep_token(p, l, base + wave * 4 + j, lane);
  }
}

template <int KIND> DI void lowrank_tile(KP p, int l, int rem, char* smem) {
  const int lane = tidx() & 63, wave = tidx() >> 6, wf = wave >> 1, wt = wave & 1, r = lane & 31, h = lane >> 5;
  const int ft = rem & 1, tt = rem >> 1;
  const h16 *W, *X; constexpr int K = (KIND == 4) ? 128 : 64;
  if (KIND < 2) { W = p.wt_wup + (size_t)(l * 2 + KIND) * RW * 64; X = p.tw + KIND * 64; }
  else if (KIND < 4) { W = p.wt_aup + (size_t)(l * 2 + KIND - 2) * RW * 64; X = p.ad + (KIND - 2) * 64; }
  else { W = p.wt_gup + (size_t)l * RW * 128; X = p.sg; }
  f32x16 acc[2][2];
  gemm_mainloop<2>(W + (size_t)ft * 128 * K, K, X + (size_t)tt * 128 * 128, 128, K, smem, acc);
  char* tw_ = g_stage1 + wave * 9216;
#pragma unroll
  for (int fi = 0; fi < 2; ++fi)
#pragma unroll
    for (int ti = 0; ti < 2; ++ti) {
      char* buf = tw_ + ((fi * 2 + ti) & 1) * 4608;
#pragma unroll
      for (int g = 0; g < 4; ++g) {
        f32x4 a = {acc[fi][ti][4 * g], acc[fi][ti][4 * g + 1], acc[fi][ti][4 * g + 2], acc[fi][ti][4 * g + 3]};
        *(f32x4*)(buf + r * 144 + (4 * h + 8 * g) * 4) = a;
      }
      asm volatile("" ::: "memory");
      __builtin_amdgcn_wave_barrier();
      const int nb32 = ft * 128 + wf * 64 + fi * 32;
#pragma unroll
      for (int q = 0; q < 4; ++q) {
        const int tl = q * 8 + (lane >> 3), ch = lane & 7;
        const int tok = tt * 128 + wt * 64 + ti * 32 + tl, n = nb32 + ch * 4;
        const f32x4 a = *(const f32x4*)(buf + tl * 144 + ch * 16);
        const size_t off = (size_t)tok * RW + n;
        if (KIND < 2) {
          const f32x4 w0 = *(const f32x4*)(p.w0 + (l * 2 + KIND) * RW + n);
          f32x4 o;
#pragma unroll
          for (int j = 0; j < 4; ++j) o[j] = __expf(-0.6065306597126334f * sigmoidf_(w0[j] + a[j]));
          *(f32x4*)(p.dr + ((size_t)KIND * NTOK + tok) * 768 + (n >> 6) * 192 + (n & 63)) = o;
        } else if (KIND < 4) {
          constexpr int d = KIND - 2;
          const f32x4 a0 = *(const f32x4*)(p.a0 + (l * 2 + d) * RW + n);
          const f32x4 ka = *(const f32x4*)(p.k_a + l * RW + n);
          const f32x4 kk = *(const f32x4*)(p.sh + (size_t)tok * 768 + (n >> 6) * 192 + (n & 63));
          const f32x4 kx = *(const f32x4*)(p.kx + off);
          f32x4 ob, ok;
#pragma unroll
          for (int j = 0; j < 4; ++j) { const float av = sigmoidf_(a0[j] + a[j]); ob[j] = kk[j] * av; ok[j] = kx[j] * (1.f + (av - 1.f) * ka[j]); }
          float* drp = p.dr + ((size_t)d * NTOK + tok) * 768 + (n >> 6) * 192 + (n & 63);
          *(f32x4*)(drp + 64) = ob;
          *(f32x4*)(drp + 128) = ok;
        } else {
          *(f32x4*)(p.gg + off) = a;
        }
      }
      asm volatile("" ::: "memory");
      __builtin_amdgcn_wave_barrier();
    }
}
DI void fourierB_tile(KP p, int c, char* smem) {
  const int lane = tidx() & 63, wave = tidx() >> 6, wf = wave >> 1, wt = wave & 1, r = lane & 31, h = lane >> 5;
  const int g4 = c & 3, tt = c >> 2;
  f32x16 acc[2][2];
  gemm_mainloop<2>(p.cs64t, 128, p.pq + (size_t)tt * 128 * 512 + g4 * 128, 512, 128, smem, acc);
  if (wf == 0) {
#pragma unroll
    for (int fi = 0; fi < 2; ++fi)
#pragma unroll
      for (int ti = 0; ti < 2; ++ti) {
        const int n = fi * 32 + 4 * h;
        const int tok = tt * 128 + wt * 64 + ti * 32 + r;
        const float sc = (tok < NCTX) ? (1.f / 128.f) : 0.0027621358640099515f;
        h16* dst = p.hm + (size_t)tok * DM + 768 + g4 * 64 + n;
#pragma unroll
        for (int g = 0; g < 4; ++g)
          *(half4*)(dst + 8 * g) = to_half4(acc[fi][ti][4 * g] * sc, acc[fi][ti][4 * g + 1] * sc, acc[fi][ti][4 * g + 2] * sc, acc[fi][ti][4 * g + 3] * sc);
      }
  }
}
DI void phase_mix_b(KP p, int l, char* smem) {
  const int G = gridDim.x;
  for (int it = first_item(0); it < 192; it += G) lowrank_tile<0>(p, l, it, smem);
  for (int it = first_item(192); it < 192; it += G) lowrank_tile<1>(p, l, it, smem);
  for (int it = first_item(384); it < 192; it += G) lowrank_tile<2>(p, l, it, smem);
  for (int it = first_item(576); it < 192; it += G) lowrank_tile<3>(p, l, it, smem);
  for (int it = first_item(768); it < 192; it += G) lowrank_tile<4>(p, l, it, smem);
}

DI void scan_block_task(KP p, int l, bool lat, int unit, int quarter, char* smem) {
  const size_t PL = (size_t)NTOK * RW;
  const int tid = tidx(), lane = tid & 63, wave = tid >> 6;
  const int dir = unit & 1, hh = (unit >> 1) & 3, b = unit >> 3;
  const int T = lat ? 2048 : 256, tok0 = lat ? NCTX + b * 2048 : b * 256;
  const int rl = lane >> 4, cgp = lane & 15, row = quarter * 16 + wave * 4 + rl, col0 = cgp * 4;
  float* lds = (float*)smem;
  f32x4 S = {0.f, 0.f, 0.f, 0.f};
  if (lat) S = *(const f32x4*)(p.state_rwkv + ((((size_t)(b * NL + l) * 2 + dir) * 4 + hh) * 64 + row) * 64 + col0);
  const float* gbase = p.dr;
  const int sh_off = (int)(p.sh - p.dr);
  const int nch = T >> 3;
  const int tstep = dir ? -1 : 1, tfirst = tok0 + (dir ? T - 1 : 0);
  int goff[3];
#pragma unroll
  for (int i = 0; i < 3; ++i) {
    const int idx = i * 256 + tid, st = idx / 96, within = idx - st * 96;
    goff[i] = tstep * st * 768 + ((within < 48) ? sh_off + hh * 192 + within * 4 : dir * NTOK * 768 + hh * 192 + (within - 48) * 4);
  }
  f32x4 pf[4][3];
  auto issue = [&](f32x4 (&q)[3], int ch) {
    const int cc = (ch < nch) ? ch : nch - 1;
    const int tk0 = (tfirst + tstep * (cc * 8)) * 768;
#pragma unroll
    for (int i = 0; i < 3; ++i) q[i] = *(const f32x4*)(gbase + (tk0 + goff[i]));
  };
  auto stash = [&](const f32x4 (&q)[3], int buf) {
#pragma unroll
    for (int i = 0; i < 3; ++i) *(f32x4*)(lds + buf * 3072 + (i * 256 + tid) * 4) = q[i];
  };
  float* yout = p.yy + (size_t)dir * PL + hh * 64 + row;
  issue(pf[0], 0);
  stash(pf[0], 0);
  issue(pf[0], 1); issue(pf[1], 2); issue(pf[2], 3); issue(pf[3], 4);
  __syncthreads();
  auto chunk = [&](f32x4 (&q)[3], int ch) {
    stash(q, (ch + 1) & 1);
    issue(q, ch + 5);
    asm volatile("" ::: "memory");
    const float* cb = lds + (ch & 1) * 3072;
    float yv = 0.f;
    f32x4 k = *(const f32x4*)(cb + col0), w = *(const f32x4*)(cb + 192 + col0), d = *(const f32x4*)(cb + 320 + col0);
    f32x4 bb = *(const f32x4*)(cb + 256 + col0), rr = *(const f32x4*)(cb + 64 + col0);
    float v = cb[128 + row];
#pragma unroll
    for (int st = 0; st < 8; ++st) {
      const float* np = cb + (st < 7 ? st + 1 : st) * 384;
      const f32x4 nk = *(const f32x4*)(np + col0), nw = *(const f32x4*)(np + 192 + col0), nd = *(const f32x4*)(np + 320 + col0);
      const f32x4 nb = *(const f32x4*)(np + 256 + col0), nr = *(const f32x4*)(np + 64 + col0);
      const float nv = np[128 + row];
      const f32x4 t = S * k;
      float sa = (t[0] + t[1]) + (t[2] + t[3]);
      const f32x4 e = S * w + d * v;
      sa = reduce16(sa);
      S = e - bb * sa;
      const f32x4 u = S * rr;
      float y = (u[0] + u[1]) + (u[2] + u[3]);
      y = reduce16(y);
      yv = (cgp == st) ? y : yv;
      k = nk; w = nw; d = nd; bb = nb; rr = nr; v = nv;
    }
    if (cgp < 8) yout[(size_t)(tfirst + tstep * (ch * 8 + cgp)) * RW] = yv;
    __syncthreads();
  };
  for (int ch = 0; ch < nch; ch += 4) { chunk(pf[0], ch); chunk(pf[1], ch + 1); chunk(pf[2], ch + 2); chunk(pf[3], ch + 3); }
  if (!lat) *(f32x4*)(p.out_s + ((((size_t)(b * NL + l) * 2 + dir) * 4 + hh) * 64 + row) * 64 + col0) = S;
}
DI void phase_scan(KP p, int l, char* smem) {
  const int bx = blockIdx.x, G = gridDim.x;
  if (bx < 128) {
    __builtin_amdgcn_s_setprio(3);
    scan_block_task(p, l, true, (bx & 7) + 8 * (bx >> 5), (bx >> 3) & 3, smem);
    __builtin_amdgcn_s_setprio(0);
  } else {
    const int nb = G - 128, me = bx - 128;
    const int ord = (G == 512) ? (bx >= 256 && bx < 384 ? bx - 256 : (bx < 256 ? bx : bx - 128)) : me;
    for (int c = ord; c < 512; c += nb) { const int j = c >> 3; scan_block_task(p, l, false, (c & 7) + 8 * (j >> 2), j & 3, smem); }
    if (G == 512 && bx >= 256 && bx < 384) return;
    const int nw2 = (G == 512) ? 256 : nb;
    const int me3 = (G == 512) ? (bx < 256 ? bx - 128 : bx - 256) : me;
    for (int it = me3; it < 512; it += nw2) attn_item(p, l, it);
    for (int it = (me3 + nw2 / 2) % nw2; it < 256; it += nw2) fourierA_item<true>(p, it, smem);
    for (int it = me3; it < 256; it += nw2) attn_item(p, l, 512 + it);
    for (int it = me3; it < 128; it += nw2) fourierA_item<false>(p, 256 + it, smem);
  }
}

DI void phase_rwkv_post(KP p, int l) {
  const int lane = tidx() & 63, wave = tidx() >> 6;
  const size_t PL = (size_t)NTOK * RW;
  const int c = lane * 4;
  const f32x4 lg = *(const f32x4*)(p.ln_g + l * RW + c), lb = *(const f32x4*)(p.ln_b + l * RW + c);
  for (int tok = blockIdx.x * 4 + wave; tok < NTOK; tok += gridDim.x * 4) {
    const size_t off = (size_t)tok * RW + c;
    f32x4 y = *(const f32x4*)(p.yy + off) + *(const f32x4*)(p.yy + PL + off);
    float s = y[0] + y[1] + y[2] + y[3];
    s = reduce16(s);
    const float mean = s * (1.f / 64.f);
    f32x4 dlt = y - mean;
    float vs = dlt[0] * dlt[0] + dlt[1] * dlt[1] + dlt[2] * dlt[2] + dlt[3] * dlt[3];
    vs = reduce16(vs);
    const float rs = rsqrtf(vs * (1.f / 64.f) + 64e-5f);
    const float bon = p.bonus[(size_t)tok * 4 + (lane >> 4)];
    const f32x4 vv = *(const f32x4*)(p.sh + (size_t)tok * 768 + (lane >> 4) * 192 + 128 + (lane & 15) * 4), gg = *(const f32x4*)(p.gg + off);
    float o[4];
#pragma unroll
    for (int j = 0; j < 4; ++j) o[j] = (dlt[j] * rs * lg[j] + lb[j] + bon * vv[j]) * gg[j];
    *(half4*)(p.hm + (size_t)tok * DM + 512 + c) = to_half4(o[0], o[1], o[2], o[3]);
  }
}
DI void phase_post(KP p, int l, char* smem) {
  for (int it = blockIdx.x; it < 384; it += gridDim.x) fourierB_tile(p, it, smem);
  phase_rwkv_post(p, l);
}

DI void run_phase(KP p, int ph, char* smem) {
#ifdef ONLY_SP
  const int l = (ph - 1) / 10, sp = ONLY_SP;
  if (ONLY_SP == 10) { phase_prep(p, smem); return; }
  if (ONLY_SP == 11) { phase_final_norm(p); return; }
#else
  if (ph == 0) { phase_prep(p, smem); return; }
  if (ph == NPH - 1) { phase_final_norm(p); return; }
  const int l = (ph - 1) / 10, sp = (ph - 1) % 10;
#endif
  switch (sp) {
    case 0: phase_pre(p); break;
    case 1: phase_inproj(p, l, smem); break;
    case 2: phase_mix_a(p, l, smem); break;
    case 3: phase_mix_b(p, l, smem); break;
    case 4: phase_scan(p, l, smem); break;
    case 5: phase_post(p, l, smem); break;
    case 6: phase_gemm_residual(p, l, p.wt_out + (size_t)l * DM * DM, p.hm, DM, 2, p.hm2, p.ssq + (size_t)(NL + l) * NTOK, p.norm_ffn_g + l * DM, l, 4, smem); break;
    case 7: break;
    case 8: phase_ffn_in(p, l, smem); break;
    case 9: phase_gemm_residual(p, l, p.wt_f2 + (size_t)l * DM * DFF, p.act, DFF, 5, (l + 1 < NL) ? p.hm : (h16*)nullptr, p.ssq + (size_t)(l + 1 < NL ? l + 1 : 0) * NTOK,
                                p.norm_mix_g + (l + 1 < NL ? l + 1 : 0) * DM, (l + 1 < NL ? l + 1 : 0), 1, smem); break;
  }
}
DI bool phase_skipped(int ph) {
  if (ph == 0 || ph == NPH - 1) return false;
  const int l = (ph - 1) / 10, sp = (ph - 1) % 10;
  return sp == 7 || (sp == 0 && l > 0);
}

__global__ void __launch_bounds__(256, 2) hybrid_mega(Params p, int ph_begin, int ph_end) {
  char* smem = g_stage0;
  cg::grid_group grid = cg::this_grid();
  const __attribute__((address_space(4))) Params* kp = (const __attribute__((address_space(4))) Params*)__builtin_amdgcn_kernarg_segment_ptr();
  XcdBarrier xb = xcd_barrier_post(kp->bar);
  for (int ph = ph_begin; ph < ph_end; ++ph) {
    if (phase_skipped(ph)) continue;
    int z; asm volatile("s_mov_b32 %0, 0" : "=s"(z));
    run_phase(kp[z], ph, smem);
#ifdef REPEAT_SP
    if ((ph > 0 && ph < NPH - 1 && (ph - 1) % 10 == REPEAT_SP) || (REPEAT_SP == 10 && ph == 0)) { __syncthreads(); run_phase(kp[z], ph, smem); }
#endif
    if (ph + 1 < ph_end) {
      if (ph_begin < 0) grid.sync();
      xcd_barrier(xb);
    }
  }
}

extern "C" void kernel_launch(void* const* d_in, const int* in_sizes, int n_in, void* d_out, int out_size, void* d_ws, size_t ws_size, hipStream_t stream) {
  static int grid_blocks = 0;
  if (!grid_blocks) {
    int dev = 0, cus = 0, per_cu = 0;
    hipGetDevice(&dev);
    hipDeviceGetAttribute(&cus, hipDeviceAttributeMultiprocessorCount, dev);
    hipOccupancyMaxActiveBlocksPerMultiprocessor(&per_cu, hybrid_mega, 256, 0);
    if (per_cu > 2) per_cu = 2;
    if (per_cu < 1) per_cu = 1;
    grid_blocks = cus * per_cu;
  }
  Params p{};
  const float* const* in = (const float* const*)d_in;
  p.x_prompt = in[0]; p.x_sample = in[1]; p.cache_k = in[2]; p.cache_v = in[3]; p.state_rwkv = in[4]; p.c = in[5]; p.c_ctx = in[6];
  p.w_ada = in[7]; p.b_ada = in[8]; p.norm_mix_g = in[9]; p.norm_ffn_g = in[10]; p.w_in = in[11]; p.w_out = in[12]; p.attn_sink = in[13];
  p.shift_w = in[14]; p.w0 = in[15]; p.w_up = in[16]; p.a0 = in[17]; p.a_up = in[18]; p.g_up = in[19]; p.k_k = in[20]; p.k_a = in[21];
  p.r_k = in[22]; p.ln_g = in[23]; p.ln_b = in[24]; p.ffn_w_in = in[25]; p.ffn_w_out = in[26]; p.norm_final_g = in[27];
  float* out = (float*)d_out;
  p.x = out;
  p.out_k = out + (size_t)NTOK * DM;
  p.out_v = p.out_k + (size_t)16 * NL * 256 * 128;
  p.out_s = p.out_v + (size_t)16 * NL * 256 * 128;
  char* ws = (char*)d_ws; size_t off = 0;
  auto alloc = [&](size_t bytes) { char* r = ws + off; off += (bytes + 255) & ~(size_t)255; return r; };
  p.wt_in = (h16*)alloc((size_t)NL * INW * DM * 2);
  p.wt_out = (h16*)alloc((size_t)NL * DM * DM * 2);
  p.wt_f1 = (h16*)alloc((size_t)NL * 2 * DFF * DM * 2);
  p.wt_f2 = (h16*)alloc((size_t)NL * DM * DFF * 2);
  p.wt_wup = (h16*)alloc((size_t)NL * 2 * RW * 64 * 2);
  p.wt_aup = (h16*)alloc((size_t)NL * 2 * RW * 64 * 2);
  p.wt_gup = (h16*)alloc((size_t)NL * RW * 128 * 2);
  p.cs64t = (h16*)alloc(128 * 128 * 2);
  p.cs_lat = (h16*)alloc((size_t)4096 * 2048 * 2);
  p.cs_ctx = (h16*)alloc(512 * 256 * 2);
  p.ck = (h16*)alloc((size_t)4 * NL * 512 * 128 * 2);
  p.cvt = (h16*)alloc((size_t)4 * NL * 512 * 128 * 2);
  p.mod = (float*)alloc((size_t)NL * 5 * 6144 * 4);
  p.rope = (float*)alloc(2048 * 4);
  p.hm = (h16*)alloc((size_t)NTOK * DM * 2);
  char* qkvz = alloc((size_t)NTOK * 1024 * 2);
  p.qh = (h16*)qkvz; p.kh = p.qh + (size_t)NTOK * 512; p.vt = p.kh + (size_t)NTOK * 128; p.zt = p.vt + (size_t)NTOK * 128;
  p.yy = (float*)alloc((size_t)NTOK * RW * 4 * 2);
  p.pq = (h16*)alloc((size_t)NTOK * 512 * 2);
  char* big = alloc((size_t)NTOK * RW * 4 * 6);
  p.ur = (float*)big; p.dr = (float*)big; p.act = (h16*)big;
  p.sh = (float*)alloc((size_t)NTOK * 768 * 4);
  p.kx = (float*)alloc((size_t)NTOK * RW * 4);
  p.gg = (float*)alloc((size_t)NTOK * RW * 4);
  p.bonus = (float*)alloc((size_t)NTOK * 4 * 4);
  p.tw = (h16*)alloc((size_t)NTOK * 128 * 2);
  p.ad = (h16*)alloc((size_t)NTOK * 128 * 2);
  p.sg = (h16*)alloc((size_t)NTOK * 128 * 2);
  p.bar = (unsigned*)alloc(XCD_BAR_WORDS * 4);
  p.hm2 = (h16*)alloc((size_t)NTOK * DM * 2);
  p.ssq = (float*)alloc((size_t)2 * NL * NTOK * 4);
  p.bias_in = (float*)alloc((size_t)NL * 5 * INW * 4);
  p.bias_f1 = (float*)alloc((size_t)NL * 5 * 2 * DFF * 4);
  if (off > ws_size) { fprintf(stderr, "workspace too small: need %zu have %zu\n", off, ws_size); return; }
  hipMemsetAsync(p.bar, 0, XCD_BAR_WORDS * 4, stream);
#if N_LAUNCH_MODE == 1
  for (int ph = 0; ph < NPH; ++ph) hipLaunchKernelGGL(hybrid_mega, dim3(grid_blocks), dim3(256), 0, stream, p, ph, ph + 1);
#else
  int b0 = 0, b1 = NPH;
  void* args[] = {&p, &b0, &b1};
  hipError_t e = hipLaunchCooperativeKernel((void*)hybrid_mega, dim3(grid_blocks), dim3(256), args, 0, stream);
  if (e != hipSuccess) fprintf(stderr, "cooperative launch failed: %s (grid %d)\n", hipGetErrorString(e), grid_blocks);
#endif
}
```
